# Optimizing an MI355X kernel written in HIP

```python
import math
import jax
import jax.numpy as jnp
from jax import lax
import numpy as np

D_MODEL = 1024
BATCH = 8
SEQ = 4096
DEPTH = 1
DEC_BATCH = 8
DEC_SEQ = 64
PAST_LEN = 2048

CHUNK = 64
Q_BLOCK = 128
SSD_HEADS = 8
SSD_HEAD_DIM = 64
SSD_WIDTH = SSD_HEADS * SSD_HEAD_DIM
SSD_GROUPS = 2
SSD_STATE = 128
SSD_CONV = 4
SSD_BLOCK = CHUNK
CONV_CH = SSD_WIDTH + 2 * SSD_GROUPS * SSD_STATE
ATT_HEADS = 4
ATT_HEAD_DIM = 64
ATT_WIDTH = ATT_HEADS * 2 * ATT_HEAD_DIM
MIX_WIDTH = SSD_WIDTH + ATT_WIDTH
IN_COLS = SSD_WIDTH + CONV_CH + SSD_HEADS + 3 * ATT_WIDTH
IN_SPLITS = (SSD_WIDTH,
             SSD_WIDTH + CONV_CH,
             SSD_WIDTH + CONV_CH + SSD_HEADS,
             SSD_WIDTH + CONV_CH + SSD_HEADS + ATT_WIDTH,
             SSD_WIDTH + CONV_CH + SSD_HEADS + 2 * ATT_WIDTH)
D_FF = 2816
N_MOD = 9
EPS = 1e-6

kernel_name = 'hymba_ssd_diffattn_macaron_stream'


def rmsnorm(x, w):
    xf = x.astype(jnp.float32)
    y = xf * lax.rsqrt(jnp.mean(xf * xf, axis=-1, keepdims=True) + EPS)
    return (y * w.astype(jnp.float32)).astype(x.dtype)


def rmsnorm_plain(x):
    xf = x.astype(jnp.float32)
    return xf * lax.rsqrt(jnp.mean(xf * xf, axis=-1, keepdims=True) + EPS)


def modulate(x, shift, scale):
    return x * (1.0 + scale[:, None, :]) + shift[:, None, :]


def swiglu(x, w_gu, w_down):
    g, u = jnp.split(x @ w_gu, 2, axis=-1)
    return (jax.nn.silu(g) * u) @ w_down


def causal_dwconv(xpad, w, b):
    y = lax.conv_general_dilated(xpad, w[:, None, :].astype(xpad.dtype), (1,), 'VALID',
                                 dimension_numbers=('NWC', 'WIO', 'NWC'),
                                 feature_group_count=xpad.shape[-1])
    return y + b


def ssd_scan(x, dt, A, B, C, h0):
    b, L, H, P = x.shape
    G, N = B.shape[-2:]
    R = H // G
    blk = min(SSD_BLOCK, L)
    nc = L // blk
    X = (x * dt[..., None]).reshape(b, nc, blk, G, R, P)
    dA = (dt * A).reshape(b, nc, blk, G, R)
    Bc = B.reshape(b, nc, blk, G, N)
    Cc = C.reshape(b, nc, blk, G, N)
    Acs = jnp.cumsum(dA, axis=2)
    causal = jnp.tril(jnp.ones((blk, blk), bool))[None, None, :, :, None, None]
    seg = Acs[:, :, :, None] - Acs[:, :, None, :]
    Lmat = jnp.exp(jnp.where(causal, seg, -jnp.inf))
    CB = jnp.einsum('bclgn,bcsgn->bclsg', Cc, Bc)
    y_diag = jnp.einsum('bclsg,bclsgr,bcsgrp->bclgrp', CB, Lmat, X)
    decay = jnp.exp(Acs[:, :, -1:] - Acs)
    st = jnp.einsum('bclgn,bclgr,bclgrp->bcgrpn', Bc, decay, X)
    chunk_decay = jnp.exp(Acs[:, :, -1])

    def step(h, inp):
        s_c, d_c = inp
        return h * d_c[..., None, None] + s_c, h

    h_last, h_in = lax.scan(step, h0.reshape(b, G, R, P, N),
                            (jnp.moveaxis(st, 1, 0), jnp.moveaxis(chunk_decay, 1, 0)))
    h_in = jnp.moveaxis(h_in, 0, 1)
    y_off = jnp.einsum('bclgn,bcgrpn,bclgr->bclgrp', Cc, h_in, jnp.exp(Acs))
    y = (y_diag + y_off).reshape(b, L, H, P)
    return y, h_last.reshape(b, H, P, N)


def ssd_mixer(z, xpad, dt_raw, conv_w, conv_b, dt_bias, a_log, d_skip, ssd_norm, h0):
    f32 = jnp.float32
    xBC = jax.nn.silu(causal_dwconv(xpad, conv_w, conv_b))
    b, L, _ = xBC.shape
    GN = SSD_GROUPS * SSD_STATE
    xs = xBC[..., :SSD_WIDTH].reshape(b, L, SSD_HEADS, SSD_HEAD_DIM).astype(f32)
    Bm = xBC[..., SSD_WIDTH:SSD_WIDTH + GN].reshape(b, L, SSD_GROUPS, SSD_STATE).astype(f32)
    Cm = xBC[..., SSD_WIDTH + GN:].reshape(b, L, SSD_GROUPS, SSD_STATE).astype(f32)
    dt = jax.nn.softplus(dt_raw.astype(f32) + dt_bias.astype(f32))
    A = -jnp.exp(a_log.astype(f32))
    y, h_last = ssd_scan(xs, dt, A, Bm, Cm, h0.astype(f32))
    y = y + d_skip.astype(f32)[:, None] * xs
    y = y.reshape(b, L, SSD_WIDTH) * jax.nn.silu(z.astype(f32))
    y = rmsnorm(y, ssd_norm)
    return y.astype(z.dtype), h_last


def diff_attn(q, k, v, lam, mask):
    s = jnp.einsum('bqhjd,bkhjd->bhjqk', q.astype(jnp.float32), k.astype(jnp.float32))
    s = s * (1.0 / math.sqrt(ATT_HEAD_DIM))
    if mask is not None:
        s = jnp.where(mask, s, -jnp.inf)
    p = jax.nn.softmax(s, axis=-1)
    a = p[:, :, 0] - lam * p[:, :, 1]
    return jnp.einsum('bhqk,bkhe->bqhe', a, v.astype(jnp.float32))


def diff_attn_prompt(q, k, v, lam):
    b, L = q.shape[:2]
    nblk = L // Q_BLOCK
    kchunk = jnp.arange(L) // CHUNK

    def block(i):
        start = i * Q_BLOCK
        qb = lax.dynamic_slice_in_dim(q, start, Q_BLOCK, axis=1)
        qchunk = (start + jnp.arange(Q_BLOCK)) // CHUNK
        mask = kchunk[None, :] <= qchunk[:, None]
        return diff_attn(qb, k, v, lam, mask)

    out = lax.map(block, jnp.arange(nblk))
    return jnp.moveaxis(out, 0, 1).reshape(b, L, ATT_HEADS, 2 * ATT_HEAD_DIM)


def layer(x, c, p, layer_idx, past):
    b, L, _ = x.shape
    mod = (jax.nn.silu(c) @ p['w_ada'] + p['b_ada']).reshape(b, N_MOD, D_MODEL)
    sh1, sc1, g1 = mod[:, 0], mod[:, 1], mod[:, 2]
    sh2, sc2, g2 = mod[:, 3], mod[:, 4], mod[:, 5]
    sh3, sc3, g3 = mod[:, 6], mod[:, 7], mod[:, 8]
    h = modulate(rmsnorm(x, p['norm1']), sh1, sc1)
    x = x + 0.5 * g1[:, None, :] * swiglu(h, p['ffn1_wgu'], p['ffn1_wd'])
    u = modulate(rmsnorm(x, p['norm2']), sh2, sc2)
    z, xBC, dt_raw, q, k, v = jnp.split(u @ p['w_in'], IN_SPLITS, axis=-1)
    if past is None:
        conv_prefix = jnp.zeros((b, SSD_CONV - 1, CONV_CH), xBC.dtype)
        h0 = jnp.zeros((b, SSD_HEADS, SSD_HEAD_DIM, SSD_STATE), jnp.float32)
    else:
        k_past, v_past, h0, conv_prefix = past
    xpad = jnp.concatenate([conv_prefix.astype(xBC.dtype), xBC], axis=1)
    y_ssd, h_last = ssd_mixer(z, xpad, dt_raw, p['conv_w'], p['conv_b'], p['dt_bias'],
                              p['a_log'], p['d_skip'], p['ssd_norm'], h0)
    q = q.reshape(b, L, ATT_HEADS, 2, ATT_HEAD_DIM)
    k = k.reshape(b, L, ATT_HEADS, 2, ATT_HEAD_DIM)
    v = v.reshape(b, L, ATT_HEADS, 2 * ATT_HEAD_DIM)
    lambda_init = 0.8 - 0.6 * math.exp(-0.3 * layer_idx)
    lam = (jnp.exp(jnp.sum(p['lam_q1'].astype(jnp.float32) * p['lam_k1'].astype(jnp.float32)))
           - jnp.exp(jnp.sum(p['lam_q2'].astype(jnp.float32) * p['lam_k2'].astype(jnp.float32)))
           + lambda_init)
    if past is None:
        o = diff_attn_prompt(q, k, v, lam)
    else:
        k_all = jnp.concatenate([k_past.astype(k.dtype), k], axis=1)
        v_all = jnp.concatenate([v_past.astype(v.dtype), v], axis=1)
        o = diff_attn(q, k_all, v_all, lam, None)
    o = (rmsnorm_plain(o) * (1.0 - lambda_init)).reshape(b, L, ATT_WIDTH).astype(x.dtype)
    mix = jnp.concatenate([y_ssd, o], axis=-1) @ p['w_out']
    x = x + g2[:, None, :] * mix
    h = modulate(rmsnorm(x, p['norm3']), sh3, sc3)
    x = x + 0.5 * g3[:, None, :] * swiglu(h, p['ffn2_wgu'], p['ffn2_wd'])
    return x, (k, v, h_last, xpad[:, -(SSD_CONV - 1):])


def setup_inputs(seed: int = 0) -> dict:
    key = jax.random.key(seed)
    ks = iter(jax.random.split(key, 40))
    f32 = jnp.float32

    def nrm(shape, scale):
        return jax.random.normal(next(ks), shape, f32) * scale

    x_prompt = nrm((BATCH, SEQ, D_MODEL), 1.0)
    x_sample = nrm((DEC_BATCH, DEC_SEQ, D_MODEL), 1.0)
    cache_k = nrm((DEPTH, DEC_BATCH, PAST_LEN, ATT_HEADS, 2, ATT_HEAD_DIM), 1.0)
    cache_v = nrm((DEPTH, DEC_BATCH, PAST_LEN, ATT_HEADS, 2 * ATT_HEAD_DIM), 1.0)
    state_ssm = nrm((DEPTH, DEC_BATCH, SSD_HEADS, SSD_HEAD_DIM, SSD_STATE), 0.1)
    state_conv = nrm((DEPTH, DEC_BATCH, SSD_CONV - 1, CONV_CH), 1.0)
    c_prompt = nrm((BATCH, D_MODEL), 1.0)
    c_sample = nrm((DEC_BATCH, D_MODEL), 1.0)
    w_ada = nrm((DEPTH, D_MODEL, N_MOD * D_MODEL), 0.5 * D_MODEL ** -0.5)
    b_ada = nrm((DEPTH, N_MOD * D_MODEL), 0.02)
    norm1 = 1.0 + nrm((DEPTH, D_MODEL), 0.02)
    ffn1_wgu = nrm((DEPTH, D_MODEL, 2 * D_FF), D_MODEL ** -0.5)
    ffn1_wd = nrm((DEPTH, D_FF, D_MODEL), D_FF ** -0.5)
    norm2 = 1.0 + nrm((DEPTH, D_MODEL), 0.02)
    w_in = nrm((DEPTH, D_MODEL, IN_COLS), D_MODEL ** -0.5)
    conv_w = nrm((DEPTH, SSD_CONV, CONV_CH), SSD_CONV ** -0.5)
    conv_b = nrm((DEPTH, CONV_CH), 0.02)
    dt0 = jnp.exp(jax.random.uniform(next(ks), (DEPTH, SSD_HEADS), f32, math.log(1e-3), math.log(1e-1)))
    dt_bias = dt0 + jnp.log(-jnp.expm1(-dt0))
    a_log = jnp.log(jax.random.uniform(next(ks), (DEPTH, SSD_HEADS), f32, 1.0, 16.0))
    d_skip = 1.0 + nrm((DEPTH, SSD_HEADS), 0.1)
    ssd_norm = 1.0 + nrm((DEPTH, SSD_WIDTH), 0.02)
    lam_q1 = nrm((DEPTH, ATT_HEAD_DIM), 0.1)
    lam_k1 = nrm((DEPTH, ATT_HEAD_DIM), 0.1)
    lam_q2 = nrm((DEPTH, ATT_HEAD_DIM), 0.1)
    lam_k2 = nrm((DEPTH, ATT_HEAD_DIM), 0.1)
    w_out = nrm((DEPTH, MIX_WIDTH, D_MODEL), MIX_WIDTH ** -0.5)
    norm3 = 1.0 + nrm((DEPTH, D_MODEL), 0.02)
    ffn2_wgu = nrm((DEPTH, D_MODEL, 2 * D_FF), D_MODEL ** -0.5)
    ffn2_wd = nrm((DEPTH, D_FF, D_MODEL), D_FF ** -0.5)
    final_norm = 1.0 + nrm((D_MODEL,), 0.02)
    return {'x_prompt': x_prompt, 'x_sample': x_sample, 'cache_k': cache_k, 'cache_v': cache_v,
            'state_ssm': state_ssm, 'state_conv': state_conv, 'c_prompt': c_prompt, 'c_sample': c_sample,
            'w_ada': w_ada, 'b_ada': b_ada, 'norm1': norm1, 'ffn1_wgu': ffn1_wgu, 'ffn1_wd': ffn1_wd,
            'norm2': norm2, 'w_in': w_in, 'conv_w': conv_w, 'conv_b': conv_b, 'dt_bias': dt_bias,
            'a_log': a_log, 'd_skip': d_skip, 'ssd_norm': ssd_norm, 'lam_q1': lam_q1, 'lam_k1': lam_k1,
            'lam_q2': lam_q2, 'lam_k2': lam_k2, 'w_out': w_out, 'norm3': norm3, 'ffn2_wgu': ffn2_wgu,
            'ffn2_wd': ffn2_wd, 'final_norm': final_norm}


def reference(x_prompt, x_sample, cache_k, cache_v, state_ssm, state_conv, c_prompt, c_sample,
              w_ada, b_ada, norm1, ffn1_wgu, ffn1_wd, norm2, w_in, conv_w, conv_b, dt_bias,
              a_log, d_skip, ssd_norm, lam_q1, lam_k1, lam_q2, lam_k2, w_out, norm3, ffn2_wgu,
              ffn2_wd, final_norm):
    hp, hs = x_prompt, x_sample
    st_p, st_s = [], []
    for l in range(DEPTH):
        p = {'w_ada': w_ada[l], 'b_ada': b_ada[l], 'norm1': norm1[l], 'ffn1_wgu': ffn1_wgu[l],
             'ffn1_wd': ffn1_wd[l], 'norm2': norm2[l], 'w_in': w_in[l], 'conv_w': conv_w[l],
             'conv_b': conv_b[l], 'dt_bias': dt_bias[l], 'a_log': a_log[l], 'd_skip': d_skip[l],
             'ssd_norm': ssd_norm[l], 'lam_q1': lam_q1[l], 'lam_k1': lam_k1[l], 'lam_q2': lam_q2[l],
             'lam_k2': lam_k2[l], 'w_out': w_out[l], 'norm3': norm3[l], 'ffn2_wgu': ffn2_wgu[l],
             'ffn2_wd': ffn2_wd[l]}
        hp, sp = layer(hp, c_prompt, p, l, None)
        hs, ss = layer(hs, c_sample, p, l, (cache_k[l], cache_v[l], state_ssm[l], state_conv[l]))
        st_p.append(sp)
        st_s.append(ss)
    y_prompt = rmsnorm(hp, final_norm)
    y_sample = rmsnorm(hs, final_norm)
    new_k_prompt = jnp.stack([s[0] for s in st_p])
    new_v_prompt = jnp.stack([s[1] for s in st_p])
    ssm_prompt = jnp.stack([s[2] for s in st_p])
    conv_prompt = jnp.stack([s[3] for s in st_p])
    new_k_sample = jnp.stack([s[0] for s in st_s])
    new_v_sample = jnp.stack([s[1] for s in st_s])
    ssm_sample = jnp.stack([s[2] for s in st_s])
    conv_sample = jnp.stack([s[3] for s in st_s])
    return (y_prompt, y_sample, new_k_prompt, new_v_prompt, ssm_prompt, conv_prompt,
            new_k_sample, new_v_sample, ssm_sample, conv_sample)
```

```cpp
#include <hip/hip_runtime.h>
#include <hip/hip_cooperative_groups.h>
#include <cstdio>
#include <cstdint>
constexpr int NWAVES = 8;
constexpr int DM = 1024, MP = 32768, MS = 512, MT = MP + MS, DFF = 2816, NGU = 2 * DFF, NIN = 3072, INC = 3080, NCH = 520;
constexpr float EPSN = 1e-6f;
constexpr int N_PHASES = 16;
constexpr size_t O_Y = 0, O_NKP = 34078720, O_NVP = 50855936, O_SSMP = 67633152, O_CONVP = 68157440, O_NKS = 68182016, O_NVS = 68444160, O_SSMS = 68706304, O_CONVS = 69230592, O_TOTAL = 69255168;
constexpr size_t MiB = 1u << 20;
constexpr size_t WS_CTL = 0, CTL_ZERO_BYTES = 64 * 1024;
constexpr size_t WS_MOD = 1 * MiB, WS_MISC = 1 * MiB + 640 * 1024, WS_DT = 2 * MiB;
constexpr size_t WS_WGU1 = 4 * MiB, WS_WD1 = 15 * MiB, WS_WIN = 21 * MiB, WS_WOUT = 27 * MiB, WS_WGU2 = 29 * MiB, WS_WD2 = 40 * MiB;
constexpr size_t WS_H = 46 * MiB, WS_ACT = 111 * MiB;
constexpr size_t WS_XBC = 111 * MiB, WS_Z = 176 * MiB, WS_Q = 209 * MiB, WS_K = 243 * MiB;
constexpr size_t WS_V = 290 * MiB, WS_KS = 322 * MiB, WS_VS = 339 * MiB, WS_XT = 356 * MiB, WS_BN = 389 * MiB, WS_CN = 406 * MiB, WS_BT = 423 * MiB, WS_HST = 440 * MiB;
constexpr size_t WS_ATTO = 111 * MiB  , WS_ATTOS = 505 * MiB, WS_END = 509 * MiB;
static_assert(WS_ACT + (size_t)MT * DFF * 2 <= WS_V && WS_K + (size_t)MP * 512 * 2 <= WS_V && WS_HST + (size_t)NCH * 8 * 64 * 128 * 2 <= WS_ATTOS, "ws map");
constexpr int LDS_BYTES = 147456;

constexpr float SC_H8 = 8.0f, SC_WGU8 = 64.0f, SC_ACT8 = 4.0f, SC_WD8 = 128.0f;
constexpr float INV_GU = 1.0f / (SC_H8 * SC_WGU8), INV_D = 1.0f / (SC_ACT8 * SC_WD8);
__device__ __forceinline__ float clamp8(float x) { return __builtin_amdgcn_fmed3f(x, -448.0f, 448.0f); }
__device__ __forceinline__ unsigned pk4_fp8(float a, float b, float c, float d) {
    int w = __builtin_amdgcn_cvt_pk_fp8_f32(clamp8(a), clamp8(b), 0, false); w = __builtin_amdgcn_cvt_pk_fp8_f32(clamp8(c), clamp8(d), w, true); return (unsigned)w; }
namespace pg8 {
#define PG8_LAS __attribute__((address_space(3)))
typedef unsigned short bf16_t;
typedef short bf16x8 __attribute__((ext_vector_type(8)));
typedef float f32x4 __attribute__((ext_vector_type(4)));
typedef unsigned u32x4 __attribute__((ext_vector_type(4)));
typedef int i32x4_t __attribute__((ext_vector_type(4)));
constexpr int BM = 256, BK = 64, HALF = 128, HTB = HALF * BK * 2  , STAGE_BYTES = 8 * HTB, NXCD = 8, WGM = 8;

__host__ __device__ __forceinline__ int lds_byte(int r, int c) { const int st = (r >> 4) * 2 + (c >> 5), rr = r & 15, cc = c & 31, ob = rr * 64 + cc * 2; return st * 1024 + (ob ^ (((ob >> 9) & 1) << 5)); }
__host__ __device__ __forceinline__ void stage_rc(int b, int& R, int& C) { const int st = b / 1024, sb = b % 1024, swz = sb ^ (((sb >> 9) & 1) << 5); R = (st >> 1) * 16 + swz / 64; C = (st & 1) * 32 + (swz % 64) / 2; }
__host__ __device__ __forceinline__ int perm32(int rho) { const int n = rho >> 4, i = rho & 15; return 8 * (i >> 2) + 4 * n + (i & 3); }

struct Unit { int pm, pn, kofs; };
struct Gemm { const bf16_t* A; const bf16_t* Bt; int M, N, K, ld; };

struct StaticOrder {
    int nM, nN, nwg, G, c;
    __host__ __device__ void init(int M, int N, int G_, int c_) { nM = M / BM; nN = N / BM; nwg = nM * nN; G = G_; c = c_; }
    __host__ __device__ bool next(int i, Unit& u) const {
        const long L = (long)i * G + c; if (L >= nwg) return false;
        int wgid = (int)L; { const int q = nwg / NXCD, r = nwg % NXCD, xcd = wgid % NXCD, off = wgid / NXCD; wgid = (xcd < r ? xcd * (q + 1) : r * (q + 1) + (xcd - r) * q) + off; }
        const int nig = WGM * nN, gid = wgid / nig, fm = gid * WGM, gsz = (nM - fm) < WGM ? (nM - fm) : WGM;
        u.pm = fm + ((wgid % nig) % gsz); u.pn = (wgid % nig) / gsz; u.kofs = 0; return true;
    }
    __device__ __forceinline__ void a_ready(const Unit&) const {}
    __device__ __forceinline__ void done(const Unit&) const {}
};

struct SplitOrder {
    int nN, S, kchunk, pm0, nunits, G, c;
    __host__ __device__ void init(int nM, int N, int S_, int kchunk_, int pm0_, int G_, int c_) { nN = N / BM; S = S_; kchunk = kchunk_; pm0 = pm0_; nunits = nM * nN * S_; G = G_; c = c_; }
    __host__ __device__ bool next(int i, Unit& u) const {
        const int L = i * G + c; if (L >= nunits) return false;
        const int ks = L % S, t = L / S; u.pn = t % nN; u.pm = pm0 + t / nN; u.kofs = ks * kchunk; return true;
    }
    __device__ __forceinline__ void a_ready(const Unit&) const {}
    __device__ __forceinline__ void done(const Unit&) const {}
};

__device__ __forceinline__ unsigned cvt_pk_bf16(float lo, float hi) { unsigned r; asm volatile("v_cvt_pk_bf16_f32 %0, %1, %2" : "=v"(r) : "v"(lo), "v"(hi)); return r; }
typedef float f32x2 __attribute__((ext_vector_type(2)));
__device__ __forceinline__ const char* uni_ptr(const char* p) { const unsigned long long v = (unsigned long long)p; const unsigned lo = __builtin_amdgcn_readfirstlane((unsigned)v), hi = __builtin_amdgcn_readfirstlane((unsigned)(v >> 32)); return (const char*)(((unsigned long long)hi << 32) | lo); }
__device__ __forceinline__ void glds_s(const char* sbase, unsigned voff, unsigned lds_dst) { unsigned keep;
    asm volatile("s_mov_b32 %0, m0\n\ts_mov_b32 m0, %3\n\ts_nop 0\n\tglobal_load_lds_dwordx4 %1, %2\n\ts_mov_b32 m0, %0" : "=&s"(keep) : "v"(voff), "s"(sbase), "s"(lds_dst) : "memory"); }
typedef int i32x8_t __attribute__((ext_vector_type(8)));
template <bool F8> struct FragT { typedef bf16x8 A[4][2]; typedef bf16x8 B[2][2]; };
template <> struct FragT<true> { typedef i32x8_t A[4]; typedef i32x8_t B[2]; };
template <class Epi, class Sched, bool ALIGN_EPI = false, bool SP2 = false, bool F8 = false>
__device__ __forceinline__ void gemm_phase(PG8_LAS unsigned char* lds, const Gemm g, const Sched& S, const Epi& E) {
    int tid_ = threadIdx.x; asm volatile("" : "+v"(tid_));
    const int tid = tid_, wid = __builtin_amdgcn_readfirstlane(tid >> 6), lane = tid & 63, wr = wid >> 2, wc = wid & 3, fr = lane & 15, fq = lane >> 4;
    const int K = g.K, nt = K / BK;
    unsigned voffA, voffB;
    { int R, C; stage_rc(tid * 16, R, C); const int Rb = Epi::PERM ? ((R & ~31) + perm32(R & 31)) : R;
        voffA = (unsigned)(R * g.ld + C) * 2u; voffB = (unsigned)(Rb * g.ld + C) * 2u; }
    const size_t pstep = (size_t)64 * g.ld * 2;
    const size_t kstep = (size_t)(BK * 2);
    const size_t hstep = (size_t)HALF * g.ld * 2;
    const size_t tstep = 2 * hstep;
    const unsigned ldsbase = (unsigned)(size_t)lds;
    const unsigned ldsw = (unsigned)wid * 1024u;
    const int aoff = lds_byte(wr * 64 + fr, fq * 8), boff = lds_byte(wc * 32 + fr, fq * 8);
#define PG8_SA(b, h) (((b) * 2 + (h)) * HTB)
#define PG8_SB(b, h) ((4 + (b) * 2 + (h)) * HTB)
#define PG8_STAGE(bufoff, gbase, voff) do { const char* gb0_ = uni_ptr((const char*)(gbase)); const char* gb1_ = uni_ptr((const char*)(gbase) + pstep);     \
        __builtin_amdgcn_global_load_lds((const unsigned*)(gb0_ + (voff)), (PG8_LAS unsigned*)(lds + (bufoff) + ldsw), 16, 0, 0); \
        __builtin_amdgcn_global_load_lds((const unsigned*)(gb1_ + (voff)), (PG8_LAS unsigned*)(lds + (bufoff) + ldsw + 8192), 16, 0, 0); } while (0)
#define PG8_CAT(lo, hi) __builtin_shufflevector(__builtin_bit_cast(i32x4_t, lo), __builtin_bit_cast(i32x4_t, hi), 0, 1, 2, 3, 4, 5, 6, 7)
#define PG8_LDA(dst, b, h) do { _Pragma("unroll") for (int m = 0; m < 4; ++m) { if constexpr (F8) { dst[m] = PG8_CAT(*(const PG8_LAS bf16x8*)(lds + PG8_SA(b, h) + aoff + m * 2048), *(const PG8_LAS bf16x8*)(lds + PG8_SA(b, h) + aoff + m * 2048 + 1024)); } \
        else { _Pragma("unroll") for (int k = 0; k < 2; ++k) dst[m][k] = *(const PG8_LAS bf16x8*)(lds + PG8_SA(b, h) + aoff + m * 2048 + k * 1024); } } } while (0)
#define PG8_LDB(dst, b, h) do { _Pragma("unroll") for (int n = 0; n < 2; ++n) { if constexpr (F8) { dst[n] = PG8_CAT(*(const PG8_LAS bf16x8*)(lds + PG8_SB(b, h) + boff + n * 2048), *(const PG8_LAS bf16x8*)(lds + PG8_SB(b, h) + boff + n * 2048 + 1024)); } \
        else { _Pragma("unroll") for (int k = 0; k < 2; ++k) dst[n][k] = *(const PG8_LAS bf16x8*)(lds + PG8_SB(b, h) + boff + n * 2048 + k * 1024); } } } while (0)
#define PG8_MMA(ai, bj, At, Bt) do { __builtin_amdgcn_s_setprio(1); _Pragma("unroll") for (int m = 0; m < 4; ++m) _Pragma("unroll") for (int n = 0; n < 2; ++n) { \
        if constexpr (F8) { acc[ai][bj][m][n] = __builtin_amdgcn_mfma_scale_f32_16x16x128_f8f6f4(Bt[n], At[m], acc[ai][bj][m][n], 0, 0, 0, 0x7F7F7F7F, 0, 0x7F7F7F7F); } \
        else { _Pragma("unroll") for (int k = 0; k < 2; ++k) acc[ai][bj][m][n] = __builtin_amdgcn_mfma_f32_16x16x32_bf16(Bt[n][k], At[m][k], acc[ai][bj][m][n], 0, 0, 0); } } __builtin_amdgcn_s_setprio(0); } while (0)
#define PG8_WAIT_V(n) asm volatile("s_waitcnt vmcnt(" #n ")" ::: "memory")
#define PG8_WAIT_L(n) asm volatile("s_waitcnt lgkmcnt(" #n ")" ::: "memory")
#define PG8_BAR __builtin_amdgcn_s_barrier()
#define PG8_SCHED __builtin_amdgcn_sched_barrier(0)
    Unit cur, nxt; int ui = 0;
    if (!S.next(0, cur)) return;
    f32x4 acc[2][2][4][2];
#pragma unroll
    for (int a = 0; a < 2; ++a)
#pragma unroll
        for (int b = 0; b < 2; ++b)
#pragma unroll
            for (int m = 0; m < 4; ++m)
#pragma unroll
                for (int n = 0; n < 2; ++n) acc[a][b][m][n] = (f32x4){0.f, 0.f, 0.f, 0.f};
    typename FragT<F8>::A At; typename FragT<F8>::B B0, B1;
    const char* cA = (const char*)g.A + (size_t)cur.pm * tstep + (size_t)cur.kofs * 2; const char* cB = (const char*)g.Bt + (size_t)cur.pn * tstep + (size_t)cur.kofs * 2;
    S.a_ready(cur);
    if constexpr (SP2) {
        PG8_STAGE(PG8_SB(0, 0), cB, voffB); PG8_STAGE(PG8_SB(0, 1), cB + hstep, voffB); PG8_STAGE(PG8_SA(0, 0), cA, voffA); PG8_STAGE(PG8_SA(0, 1), cA + hstep, voffA);
        if (wr == 1) PG8_BAR;
        PG8_WAIT_V(2); PG8_BAR;
        PG8_STAGE(PG8_SB(1, 0), cB + kstep, voffB); PG8_STAGE(PG8_SA(1, 0), cA + kstep, voffA); PG8_STAGE(PG8_SB(1, 1), cB + hstep + kstep, voffB);
        PG8_WAIT_V(6); PG8_BAR;
    } else {
        PG8_STAGE(PG8_SB(0, 0), cB, voffB); PG8_STAGE(PG8_SA(0, 0), cA, voffA); PG8_STAGE(PG8_SB(0, 1), cB + hstep, voffB); PG8_STAGE(PG8_SA(0, 1), cA + hstep, voffA);
        if (wr == 1) PG8_BAR;
        PG8_WAIT_V(4); PG8_BAR;
        PG8_STAGE(PG8_SB(1, 0), cB + kstep, voffB); PG8_STAGE(PG8_SA(1, 0), cA + kstep, voffA); PG8_STAGE(PG8_SB(1, 1), cB + hstep + kstep, voffB);
        PG8_WAIT_V(6); PG8_BAR;
    }
    for (;;) {
        const bool has_next = S.next(ui + 1, nxt);
        const char* nA = has_next ? (const char*)g.A + (size_t)nxt.pm * tstep + (size_t)nxt.kofs * 2 : cA; const char* nB = has_next ? (const char*)g.Bt + (size_t)nxt.pn * tstep + (size_t)nxt.kofs * 2 : cB;
#pragma nounroll
        for (int t = 0; t < nt; t += 2) {
            const bool last = (t == nt - 2);
            const char* a1 = cA + (size_t)(t + 1) * kstep;
            const char* a2 = last ? nA : cA + (size_t)(t + 2) * kstep; const char* b2 = last ? nB : cB + (size_t)(t + 2) * kstep;
            const char* a3 = a2 + kstep; const char* b3 = b2 + kstep;
            if (last && has_next) S.a_ready(nxt);
            if constexpr (SP2) {
            PG8_LDB(B0, 0, 0); PG8_LDB(B1, 0, 1); PG8_SCHED; PG8_LDA(At, 0, 0); PG8_STAGE(PG8_SA(1, 1), a1 + hstep, voffA);
            PG8_WAIT_V(8); PG8_WAIT_L(0); PG8_BAR; PG8_MMA(0, 0, At, B0); PG8_MMA(0, 1, At, B1); PG8_BAR; PG8_SCHED;
            PG8_LDA(At, 0, 1); PG8_STAGE(PG8_SB(0, 0), b2, voffB); PG8_STAGE(PG8_SB(0, 1), b2 + hstep, voffB); PG8_STAGE(PG8_SA(0, 0), a2, voffA);
            PG8_WAIT_V(8); PG8_WAIT_L(0); PG8_BAR; PG8_MMA(1, 0, At, B0); PG8_MMA(1, 1, At, B1); PG8_BAR; PG8_SCHED;
            PG8_LDB(B0, 1, 0); PG8_LDB(B1, 1, 1); PG8_SCHED; PG8_LDA(At, 1, 0); PG8_STAGE(PG8_SA(0, 1), a2 + hstep, voffA);
            PG8_WAIT_V(8); PG8_WAIT_L(0); PG8_BAR; PG8_MMA(0, 0, At, B0); PG8_MMA(0, 1, At, B1); PG8_BAR; PG8_SCHED;
            PG8_LDA(At, 1, 1); PG8_STAGE(PG8_SB(1, 0), b3, voffB); PG8_STAGE(PG8_SB(1, 1), b3 + hstep, voffB); PG8_STAGE(PG8_SA(1, 0), a3, voffA);
            PG8_WAIT_V(8); PG8_WAIT_L(0); PG8_BAR; PG8_MMA(1, 0, At, B0); PG8_MMA(1, 1, At, B1); PG8_BAR; PG8_SCHED;
            } else {
            PG8_LDB(B0, 0, 0); PG8_SCHED; PG8_LDA(At, 0, 0); PG8_STAGE(PG8_SA(1, 1), a1 + hstep, voffA);
            PG8_WAIT_L(8); PG8_BAR; PG8_WAIT_L(0); PG8_MMA(0, 0, At, B0); PG8_BAR; PG8_SCHED;
            PG8_LDB(B1, 0, 1); PG8_STAGE(PG8_SB(0, 0), b2, voffB);
            PG8_BAR; PG8_WAIT_L(0); PG8_MMA(0, 1, At, B1); PG8_BAR;
            PG8_LDA(At, 0, 1); PG8_STAGE(PG8_SA(0, 0), a2, voffA);
            PG8_BAR; PG8_WAIT_L(0); PG8_MMA(1, 0, At, B0); PG8_BAR; PG8_SCHED;
            PG8_STAGE(PG8_SB(0, 1), b2 + hstep, voffB);
            PG8_WAIT_V(6); PG8_BAR; PG8_MMA(1, 1, At, B1); PG8_BAR;
            PG8_LDB(B0, 1, 0); PG8_SCHED; PG8_LDA(At, 1, 0); PG8_STAGE(PG8_SA(0, 1), a2 + hstep, voffA);
            PG8_WAIT_L(8); PG8_BAR; PG8_WAIT_L(0); PG8_MMA(0, 0, At, B0); PG8_BAR; PG8_SCHED;
            PG8_LDB(B1, 1, 1); PG8_STAGE(PG8_SB(1, 0), b3, voffB);
            PG8_BAR; PG8_WAIT_L(0); PG8_MMA(0, 1, At, B1); PG8_BAR;
            PG8_LDA(At, 1, 1); PG8_STAGE(PG8_SA(1, 0), a3, voffA);
            PG8_BAR; PG8_WAIT_L(0); PG8_MMA(1, 0, At, B0); PG8_BAR; PG8_SCHED;
            PG8_STAGE(PG8_SB(1, 1), b3 + hstep, voffB);
            PG8_WAIT_V(6); PG8_BAR; PG8_MMA(1, 1, At, B1); PG8_BAR;
            }
        }
        if constexpr (ALIGN_EPI) { if (wr == 0) PG8_BAR; }
        if constexpr (!Epi::AFTER_DRAIN) { int t2_ = threadIdx.x; asm volatile("" : "+v"(t2_)); E(acc, cur, wr, wc, t2_ & 15, (t2_ & 63) >> 4); S.done(cur); }
        if (!has_next) break;
#pragma unroll
        for (int a = 0; a < 2; ++a)
#pragma unroll
            for (int b = 0; b < 2; ++b)
#pragma unroll
                for (int m = 0; m < 4; ++m)
#pragma unroll
                    for (int n = 0; n < 2; ++n) acc[a][b][m][n] = (f32x4){0.f, 0.f, 0.f, 0.f};
        cur = nxt; cA = nA; cB = nB; ++ui;
        if constexpr (ALIGN_EPI) { if (wr == 1) PG8_BAR; }
    }
    PG8_WAIT_V(0);
    if constexpr (!ALIGN_EPI) { if (wr == 0) PG8_BAR; }
    PG8_BAR;
    if constexpr (Epi::AFTER_DRAIN) { E.fused(acc, cur, wr, wc, fr, fq, lds, wid, lane); S.done(cur); }
#undef PG8_SA
#undef PG8_SB
#undef PG8_STAGE
#undef PG8_LDA
#undef PG8_LDB
#undef PG8_MMA
#undef PG8_CAT
#undef PG8_WAIT_V
#undef PG8_WAIT_L
#undef PG8_BAR
#undef PG8_SCHED
}
}
#include <hip/hip_bf16.h>
#include <cmath>
namespace attn_body {
using bf16=__hip_bfloat16;
using bf16x8=__attribute__((ext_vector_type(8)))short;
using s16x4=__attribute__((ext_vector_type(4)))short;
using f32x16=__attribute__((ext_vector_type(16)))float;
using u32x4=__attribute__((ext_vector_type(4)))unsigned;
constexpr int D=64,KP=512,OP=1024;
constexpr int NW=8,QBLK=32,QB=QBLK*NW,KVBLK=64;
__device__ __forceinline__ int crow(int r,int hi){return (r&3)+8*(r>>2)+4*hi;}
#define SBAR() __builtin_amdgcn_sched_barrier(0)
__device__ __forceinline__ void cmask(f32x16&p0,f32x16&p1,int jb,int lim){
  const float NEG=-INFINITY;
  if(jb>lim){
  #pragma unroll
  for(int r=0;r<16;++r){p0[r]=NEG;p1[r]=NEG;} }
}

constexpr int NSLOT=3, SLOTB=8192;
constexpr int LDS_K=0, LDS_V=NSLOT*SLOTB, LDS_WS=2*NSLOT*SLOTB, LDS_OST=LDS_WS+NW*64*4, LDS_BYTES=LDS_OST+NW*4096;
constexpr float C2=0.125f*1.4426950408889634f;
__device__ __forceinline__ void glds16(const void*gsrc,unsigned lds_dst){unsigned keep;
  asm volatile("s_mov_b32 %0, m0\n\ts_mov_b32 m0, %2\n\ts_nop 0\n\tglobal_load_lds_dwordx4 %1, off\n\ts_mov_b32 m0, %0":"=&s"(keep):"v"(gsrc),"s"(lds_dst):"memory");}
__device__ __forceinline__ float max3f(float a,float b,float c){float r;asm("v_max3_f32 %0, %1, %2, %3":"=v"(r):"v"(a),"v"(b),"v"(c));return r;}
__device__ __forceinline__ float max2f(float a,float b){float r;asm("v_max_f32_e32 %0, %1, %2":"=v"(r):"v"(a),"v"(b));return r;}
__device__ __forceinline__ float fadd_s(float a,float b){float r;asm("v_add_f32_e32 %0, %1, %2":"=v"(r):"v"(a),"v"(b));return r;}
__device__ __forceinline__ float fsub_s(float a,float b){float r;asm("v_sub_f32_e32 %0, %1, %2":"=v"(r):"v"(a),"v"(b));return r;}
typedef float f32x2_t __attribute__((ext_vector_type(2))); typedef __bf16 bf16x2_t __attribute__((ext_vector_type(2)));
__device__ __forceinline__ unsigned cvtpk_s(float lo,float hi){f32x2_t v={lo,hi};bf16x2_t b=__builtin_convertvector(v,bf16x2_t);return __builtin_bit_cast(unsigned,b);}
#define WAIT_BAR(N) asm volatile("s_waitcnt vmcnt(" #N ") lgkmcnt(0)\n\ts_barrier":::"memory")

__device__ __forceinline__ void qkt(f32x16&p0,f32x16&p1,const char*Kslot,const bf16x8*qr,const f32x16&negm,int r32,int hi){
  const char*kb=Kslot+hi*1024+r32*16;
  #pragma unroll
  for(int d0=0;d0<4;++d0){
    const bf16x8 b0=*reinterpret_cast<const bf16x8*>(kb+d0*2048);
    const bf16x8 b1=*reinterpret_cast<const bf16x8*>(kb+d0*2048+512);
    if(d0==0){p0=__builtin_amdgcn_mfma_f32_32x32x16_bf16(b0,qr[0],negm,0,0,0);p1=__builtin_amdgcn_mfma_f32_32x32x16_bf16(b1,qr[0],negm,0,0,0);}
    else{p0=__builtin_amdgcn_mfma_f32_32x32x16_bf16(b0,qr[d0],p0,0,0,0);p1=__builtin_amdgcn_mfma_f32_32x32x16_bf16(b1,qr[d0],p1,0,0,0);}}
}
typedef __attribute__((address_space(3))) const char* lds_cptr;
typedef short v4i16_t __attribute__((ext_vector_type(4)));
__device__ __forceinline__ void kload8(bf16x8*kf,lds_cptr kp){
  kf[0]=*(const __attribute__((address_space(3))) bf16x8*)(kp);      kf[1]=*(const __attribute__((address_space(3))) bf16x8*)(kp+512);
  kf[2]=*(const __attribute__((address_space(3))) bf16x8*)(kp+2048); kf[3]=*(const __attribute__((address_space(3))) bf16x8*)(kp+2560);
  kf[4]=*(const __attribute__((address_space(3))) bf16x8*)(kp+4096); kf[5]=*(const __attribute__((address_space(3))) bf16x8*)(kp+4608);
  kf[6]=*(const __attribute__((address_space(3))) bf16x8*)(kp+6144); kf[7]=*(const __attribute__((address_space(3))) bf16x8*)(kp+6656);
}
__device__ __forceinline__ void kload2(bf16x8*kf,lds_cptr kp,int j){ kf[2*j]=*(const __attribute__((address_space(3))) bf16x8*)(kp+j*2048); kf[2*j+1]=*(const __attribute__((address_space(3))) bf16x8*)(kp+j*2048+512); }
__device__ __forceinline__ s16x4 vtr(lds_cptr p){ return __builtin_bit_cast(s16x4,__builtin_amdgcn_ds_read_tr16_b64_v4i16((__attribute__((address_space(3))) v4i16_t*)p)); }
__device__ __forceinline__ float rowmax(const f32x16&p0,const f32x16&p1){
  float a=max3f(p0[0],p0[1],p1[0]),b=max3f(p0[2],p0[3],p1[1]);a=max3f(a,p1[2],p1[3]);
  #pragma unroll
  for(int r=4;r<16;r+=4){a=max3f(a,p0[r],p0[r+1]);b=max3f(b,p0[r+2],p0[r+3]);a=max3f(a,p1[r],p1[r+1]);b=max3f(b,p1[r+2],p1[r+3]);}
  const float m=max2f(a,b);
  auto rr=__builtin_amdgcn_permlane32_swap(__float_as_uint(m),__float_as_uint(m),false,false);
  return max2f(__uint_as_float(rr[0]),__uint_as_float(rr[1]));
}
__device__ __forceinline__ void pv(f32x16*o,int vb,bf16x8 pa0,bf16x8 pa1,bf16x8 pa2,bf16x8 pa3){
  #pragma unroll
  for(int d0=0;d0<2;++d0){s16x4 lo[4],hi[4];
    #pragma unroll
    for(int ks=0;ks<4;++ks){
      asm volatile("ds_read_b64_tr_b16 %0,%1 offset:%c2":"=&v"(lo[ks]):"v"(vb),"i"(d0*4096+ks*1024):"memory");
      asm volatile("ds_read_b64_tr_b16 %0,%1 offset:%c2":"=&v"(hi[ks]):"v"(vb),"i"(d0*4096+ks*1024+512):"memory");}
    asm volatile("s_waitcnt lgkmcnt(0)":::"memory");SBAR();
    #define PK(k) (bf16x8){lo[k][0],lo[k][1],lo[k][2],lo[k][3],hi[k][0],hi[k][1],hi[k][2],hi[k][3]}
    o[d0]=__builtin_amdgcn_mfma_f32_32x32x16_bf16(pa0,PK(0),o[d0],0,0,0);
    o[d0]=__builtin_amdgcn_mfma_f32_32x32x16_bf16(pa1,PK(1),o[d0],0,0,0);
    o[d0]=__builtin_amdgcn_mfma_f32_32x32x16_bf16(pa2,PK(2),o[d0],0,0,0);
    o[d0]=__builtin_amdgcn_mfma_f32_32x32x16_bf16(pa3,PK(3),o[d0],0,0,0);
    #undef PK
  }
}

#ifndef ATTN_STORE16
#define ATTN_STORE16(p,v) (*(u32x4*)(p)=(v))
#endif
template<int THRL,bool PART> __device__ __forceinline__ int attn_unit(const bf16*Qb,const bf16*__restrict__ Kh,const bf16*__restrict__ Vh,bf16*Ob,const int NT,const int vlim_in,char*shm,const int s0,const bool primed,const bf16*nKh,const bf16*nVh,bf16*fuseM,const float lam){
  int tid=threadIdx.x; asm volatile("":"+v"(tid));
  const int lane=tid&63,r32=lane&31,hi=lane>>5; const int wid=__builtin_amdgcn_readfirstlane(tid>>6);
  const int vlim=(vlim_in<0)?(wid>>1):vlim_in;
  const bool act=PART?(wid<2):true;
  const bf16*Qw=Qb+(long)(wid*QBLK)*KP;
  const unsigned lds0=(unsigned)(uintptr_t)shm;
  float*wsf=(float*)(shm+LDS_WS)+wid*64;
  const bf16*ksrc=Kh+(long)lane*KP+wid*8;
  const bf16*vsrc=Vh+(long)(16*(wid&3)+(lane>>2))*KP+(wid>>2)*32+(lane&3)*8;
  const unsigned kdst=lds0+LDS_K+wid*1024, vdst=lds0+LDS_V+wid*1024;
  #define DMA_K(t,slot) glds16(ksrc+(long)(t)*KVBLK*KP,(unsigned)__builtin_amdgcn_readfirstlane(kdst+(slot)))
  #define DMA_V(t,slot) glds16(vsrc+(long)(t)*KVBLK*KP,(unsigned)__builtin_amdgcn_readfirstlane(vdst+(slot)))
  const int vb0=(int)(lds0+LDS_V)+((lane>>4)&1)*32+(lane&3)*8+(4*hi+((lane&15)>>2))*64;
  const int s1=(s0==(NSLOT-1)*SLOTB)?0:s0+SLOTB, s2=(s1==(NSLOT-1)*SLOTB)?0:s1+SLOTB;
  const char*Kbase=shm+LDS_K+s0; bf16x8 kf[8];
  const lds_cptr shm3=(lds_cptr)shm; const lds_cptr kp0=shm3+LDS_K+hi*1024+r32*16; const lds_cptr vp0=shm3+LDS_V+((lane>>4)&1)*32+(lane&3)*8+(4*hi+((lane&15)>>2))*64;
  if(!primed){DMA_K(0,s0);DMA_V(0,s0);DMA_K(1,s1);}
  bf16x8 qr[4];
  #pragma unroll
  for(int d0=0;d0<4;++d0)qr[d0]=*reinterpret_cast<const bf16x8*>(&Qw[(long)r32*KP+d0*16+hi*8]);
  float zz_=0.f;asm volatile("":"+v"(zz_));
  float mhat=zz_,l_reg=zz_;f32x16 o[2];
  _Pragma("unroll") for(int r=0;r<16;++r){o[0][r]=zz_;o[1][r]=zz_;}
  f32x16 negm;
  _Pragma("unroll") for(int r=0;r<16;++r)negm[r]=zz_;
  asm volatile("":"+v"(negm));
  #define CMASK(P0,P1,t) do{int jb_=(t)-(NT-4); if(jb_>=0)cmask(P0,P1,jb_,vlim);}while(0)
  bool resc=false;
  #define START(P0,P1) do{ const float rm=rowmax(P0,P1); resc=false; \
    { const float dl=rm; mhat=fadd_s(mhat,dl); \
      _Pragma("unroll") for(int r=0;r<16;++r){P0[r]=fsub_s(P0[r],dl);P1[r]=fsub_s(P1[r],dl);} \
      _Pragma("unroll") for(int r=0;r<16;++r)negm[r]=-mhat; asm volatile("":"+v"(negm)); } \
    _Pragma("unroll") for(int r=0;r<16;++r)P0[r]=__builtin_amdgcn_exp2f(P0[r]); }while(0)
  #define RESC() do{ if(resc){ asm volatile("s_waitcnt lgkmcnt(0)":::"memory"); \
      _Pragma("unroll") for(int d_=0;d_<2;++d_) _Pragma("unroll") for(int r=0;r<16;++r)o[d_][r]*=wsf[crow(r,hi)]; } }while(0)
  f32x16 pA0,pA1,pB0,pB1;
  int sl_prev=s0,sl_cur=s0,sl_next=s1;
  #define ROT() do{sl_prev=sl_cur;sl_cur=sl_next;sl_next=(sl_next==(NSLOT-1)*SLOTB)?0:sl_next+SLOTB;}while(0)
  if(!primed){DMA_K(2,s2);}
  WAIT_BAR(3);
  if(act){
  qkt(pA0,pA1,Kbase,qr,negm,r32,hi);asm volatile("s_nop 15\n\ts_nop 7":"+v"(pA0),"+v"(pA1));CMASK(pA0,pA1,0);
  START(pA0,pA1);
  _Pragma("unroll") for(int r=0;r<16;++r)pA1[r]=__builtin_amdgcn_exp2f(pA1[r]);
  }
  WAIT_BAR(0);
  DMA_K(3,s0);DMA_V(1,s1);
  ROT();
  if(act)kload8(kf,kp0+sl_cur);
  WAIT_BAR(2);
  s16x4 vlo[8],vhi[8]; u32x4 pw0,pw1,pw2,pw3;
  #define PKW(P,B) cvtpk_s(P[B],P[B+1])
  #define PAF(k) __builtin_bit_cast(bf16x8,pw##k)
  #define VFR(i) (bf16x8){vlo[i][0],vlo[i][1],vlo[i][2],vlo[i][3],vhi[i][0],vhi[i][1],vhi[i][2],vhi[i][3]}
  #define PIN(x) asm volatile("":"+v"(x))
  #define MX3(a,b,c) __builtin_fmaxf(__builtin_fmaxf((a),(b)),(c))
  #define GAPA(MF,A0,A1,A2,A3,W0,W1,PW) do{ MF; sacc+=A0; sacc+=A1; sacc+=A2; sacc+=A3; PIN(sacc); W0; W1; PIN(PW); SBAR(); }while(0)
  #define EX(v) __builtin_amdgcn_exp2f(v)
  #define GAPB(MF,X,B) do{ MF; X[B]=EX(X[B]); X[B+1]=EX(X[B+1]); X[B+2]=EX(X[B+2]); X[B+3]=EX(X[B+3]); PIN(X); SBAR(); }while(0)
  #define VRD(i) do{ vlo[i]=vtr(vp_+(((i)>>2)*4096+((i)&3)*1024)); vhi[i]=vtr(vp_+(((i)>>2)*4096+((i)&3)*1024+512)); }while(0)
  #define KRD(G,j) do{ if(G){ kload2(kf,kp0+sl_next,j); SBAR(); } }while(0)
  #define STEP(C0,C1,P0,P1,t,GK,GV,GL) do{ if(act){ SBAR(); \
    const lds_cptr vp_=vp0+sl_prev; \
    VRD(0); SBAR(); float sacc=(P0[0]+P0[1]); \
    GAPA(C0=__builtin_amdgcn_mfma_f32_32x32x16_bf16(kf[0],qr[0],negm,0,0,0), P0[2],P0[3],P0[4],P0[5],     pw0[0]=PKW(P0,0), pw0[1]=PKW(P0,2), pw0); \
    VRD(4); SBAR(); GAPA(C1=__builtin_amdgcn_mfma_f32_32x32x16_bf16(kf[1],qr[0],negm,0,0,0), P0[6],P0[7],P0[8],P0[9],     pw0[2]=PKW(P0,4), pw0[3]=PKW(P0,6), pw0); \
    VRD(1); SBAR(); GAPA(C0=__builtin_amdgcn_mfma_f32_32x32x16_bf16(kf[2],qr[1],C0,0,0,0),   P0[10],P0[11],P0[12],P0[13], pw1[0]=PKW(P0,8), pw1[1]=PKW(P0,10), pw1); \
    VRD(5); SBAR(); GAPA(C1=__builtin_amdgcn_mfma_f32_32x32x16_bf16(kf[3],qr[1],C1,0,0,0),   P0[14],P0[15],P1[0],P1[1],   pw1[2]=PKW(P0,12),pw1[3]=PKW(P0,14), pw1); \
    VRD(2); SBAR(); GAPA(C0=__builtin_amdgcn_mfma_f32_32x32x16_bf16(kf[4],qr[2],C0,0,0,0),   P1[2],P1[3],P1[4],P1[5],     pw2[0]=PKW(P1,0), pw2[1]=PKW(P1,2), pw2); \
    VRD(6); SBAR(); GAPA(C1=__builtin_amdgcn_mfma_f32_32x32x16_bf16(kf[5],qr[2],C1,0,0,0),   P1[6],P1[7],P1[8],P1[9],     pw2[2]=PKW(P1,4), pw2[3]=PKW(P1,6), pw2); \
    VRD(3); SBAR(); GAPA(C0=__builtin_amdgcn_mfma_f32_32x32x16_bf16(kf[6],qr[3],C0,0,0,0),   P1[10],P1[11],P1[12],P1[13], pw3[0]=PKW(P1,8), pw3[1]=PKW(P1,10), pw3); \
    VRD(7); SBAR(); GAPA(C1=__builtin_amdgcn_mfma_f32_32x32x16_bf16(kf[7],qr[3],C1,0,0,0),   P1[14],P1[15],0.f,0.f,       pw3[2]=PKW(P1,12),pw3[3]=PKW(P1,14), pw3); \
    l_reg+=sacc; } \
    if(GK){DMA_K((t)+3,sl_cur);} if(GV){DMA_V((t)+1,sl_next);} \
    if(act){ CMASK(C0,C1,t); \
    { float a=MX3(C0[0],C0[1],C1[0]),b=MX3(C0[2],C0[3],C1[1]); a=MX3(a,C1[2],C1[3]); \
      _Pragma("unroll") for(int r=4;r<16;r+=4){a=MX3(a,C0[r],C0[r+1]);b=MX3(b,C0[r+2],C0[r+3]);a=MX3(a,C1[r],C1[r+1]);b=MX3(b,C1[r+2],C1[r+3]);} \
      float rm=__builtin_fmaxf(a,b); { auto rr=__builtin_amdgcn_permlane32_swap(__float_as_uint(rm),__float_as_uint(rm),false,false); rm=__builtin_fmaxf(__uint_as_float(rr[0]),__uint_as_float(rr[1])); } \
      resc=false; \
      if(__builtin_expect(__any(rm>(float)THRL),0)){ const float dl=__builtin_fmaxf(rm,0.f); mhat+=dl; \
        _Pragma("unroll") for(int r=0;r<16;++r){C0[r]-=dl;C1[r]-=dl;} \
        _Pragma("unroll") for(int r=0;r<16;++r)negm[r]=-mhat; asm volatile("":"+v"(negm)); \
        const float f=__builtin_amdgcn_exp2f(-dl); l_reg*=f; if(hi==0)wsf[r32]=f; resc=true; } } \
    SBAR(); \
    GAPB(o[0]=__builtin_amdgcn_mfma_f32_32x32x16_bf16(PAF(0),VFR(0),o[0],0,0,0), C0,0); \
    GAPB(o[1]=__builtin_amdgcn_mfma_f32_32x32x16_bf16(PAF(0),VFR(4),o[1],0,0,0), C0,4); \
    KRD(GL,0); GAPB(o[0]=__builtin_amdgcn_mfma_f32_32x32x16_bf16(PAF(1),VFR(1),o[0],0,0,0), C0,8); \
    KRD(GL,1); GAPB(o[1]=__builtin_amdgcn_mfma_f32_32x32x16_bf16(PAF(1),VFR(5),o[1],0,0,0), C0,12); \
    KRD(GL,2); GAPB(o[0]=__builtin_amdgcn_mfma_f32_32x32x16_bf16(PAF(2),VFR(2),o[0],0,0,0), C1,0); \
    KRD(GL,3); GAPB(o[1]=__builtin_amdgcn_mfma_f32_32x32x16_bf16(PAF(2),VFR(6),o[1],0,0,0), C1,4); \
    GAPB(o[0]=__builtin_amdgcn_mfma_f32_32x32x16_bf16(PAF(3),VFR(3),o[0],0,0,0), C1,8); \
    GAPB(o[1]=__builtin_amdgcn_mfma_f32_32x32x16_bf16(PAF(3),VFR(7),o[1],0,0,0), C1,12); } \
    }while(0)
  int t=1;
  #undef CMASK
  #define CMASK(P0,P1,t) do{}while(0)
  for(;t+5<NT;t+=2){
    STEP(pB0,pB1,pA0,pA1,t,true,true,true);     WAIT_BAR(2); RESC(); ROT();
    STEP(pA0,pA1,pB0,pB1,t+1,true,true,true);   WAIT_BAR(2); RESC(); ROT();
  }
  #undef CMASK
  #define CMASK(P0,P1,t) do{int jb_=(t)-(NT-4); if(jb_>=0)cmask(P0,P1,jb_,vlim);}while(0)
  #define ENDW(tt) do{ if((tt)+3<NT){WAIT_BAR(2);} else if((tt)+2<NT){WAIT_BAR(1);} else {WAIT_BAR(0);} }while(0)
  for(;t+1<NT;t+=2){
    STEP(pB0,pB1,pA0,pA1,t,(t+3<NT),(t+1<NT),(t+1<NT));       ENDW(t);   RESC(); ROT();
    STEP(pA0,pA1,pB0,pB1,t+1,(t+4<NT),(t+2<NT),(t+2<NT));     ENDW(t+1); RESC(); ROT();
  }
  if(nKh){ const bf16*nks=nKh+(long)lane*KP+wid*8; const bf16*nvs=nVh+(long)(16*(wid&3)+(lane>>2))*KP+(wid>>2)*32+(lane&3)*8;
    const int a0=sl_next, a1=(a0==(NSLOT-1)*SLOTB)?0:a0+SLOTB, a2=(a1==(NSLOT-1)*SLOTB)?0:a1+SLOTB;
    glds16(nks,(unsigned)__builtin_amdgcn_readfirstlane(kdst+a0)); glds16(nvs,(unsigned)__builtin_amdgcn_readfirstlane(vdst+a0));
    glds16(nks+(long)KVBLK*KP,(unsigned)__builtin_amdgcn_readfirstlane(kdst+a1)); glds16(nks+2L*KVBLK*KP,(unsigned)__builtin_amdgcn_readfirstlane(kdst+a2)); }
  STEP(pB0,pB1,pA0,pA1,NT-1,false,false,false); RESC();
  if(act){ float sacc=pB0[0]+pB0[1]; _Pragma("unroll") for(int r=2;r<16;++r)sacc+=pB0[r]; _Pragma("unroll") for(int r=0;r<16;++r)sacc+=pB1[r]; l_reg+=sacc;
    pw0=(u32x4){PKW(pB0,0),PKW(pB0,2),PKW(pB0,4),PKW(pB0,6)};pw1=(u32x4){PKW(pB0,8),PKW(pB0,10),PKW(pB0,12),PKW(pB0,14)};pw2=(u32x4){PKW(pB1,0),PKW(pB1,2),PKW(pB1,4),PKW(pB1,6)};pw3=(u32x4){PKW(pB1,8),PKW(pB1,10),PKW(pB1,12),PKW(pB1,14)};
    SBAR(); pv(o,vb0+sl_cur,PAF(0),PAF(1),PAF(2),PAF(3)); }
  #undef PKW
  #undef PAF
  #undef VFR
  #undef PIN
  #undef MX3
  #undef GAPA
  #undef GAPB
  #undef EX
  #undef VRD
  #undef KRD
  #undef STEP
  #undef ENDW
  if(act){
  {auto rr=__builtin_amdgcn_permlane32_swap(__float_as_uint(l_reg),__float_as_uint(l_reg),false,false);l_reg=__uint_as_float(rr[0])+__uint_as_float(rr[1]);}
  if(hi==0)wsf[32+r32]=l_reg;asm volatile("s_waitcnt lgkmcnt(0)":::"memory");
  float rli[16];
  #pragma unroll
  for(int r=0;r<16;++r)rli[r]=__builtin_amdgcn_rcpf(wsf[32+crow(r,hi)]);
  bf16*Ow=Ob+(long)(wid*QBLK)*OP;
  { bf16*stg=(bf16*)(shm+LDS_OST)+wid*2048;
    #pragma unroll
    for(int r=0;r<16;++r){const int orow=crow(r,hi);
      #pragma unroll
      for(int d0=0;d0<2;++d0)stg[orow*64+d0*32+r32]=__float2bfloat16(o[d0][r]*rli[r]);}
    asm volatile("s_waitcnt lgkmcnt(0)":::"memory");
    if(!fuseM){
    #pragma unroll
    for(int i=0;i<4;++i){const int row=i*8+(lane>>3),ch=lane&7; const u32x4 v=*(const u32x4*)(stg+row*64+ch*8); ATTN_STORE16(Ow+(long)row*OP+ch*8,v);}
    } else {
    asm volatile("s_waitcnt vmcnt(0)":::"memory"); __builtin_amdgcn_fence(__ATOMIC_ACQUIRE,"agent");
    bf16*Mw=fuseM+(long)(wid*QBLK)*OP;
    #pragma unroll
    for(int i=0;i<4;++i){const int row=i*8+(lane>>3),ch=lane&7; const u32x4 v=*(const u32x4*)(stg+row*64+ch*8);
      const bf16*gp=Ow+(long)row*OP+ch*8; const u32x4 a=*(const u32x4*)(gp-192), c1=*(const u32x4*)(gp-128), b=*(const u32x4*)(gp-64);
      float d0[8],d1[8],ss=0.f;
      #pragma unroll
      for(int q=0;q<4;++q){ d0[2*q]=__uint_as_float(a[q]<<16)-lam*__uint_as_float(b[q]<<16); d0[2*q+1]=__uint_as_float(a[q]&0xffff0000u)-lam*__uint_as_float(b[q]&0xffff0000u);
        d1[2*q]=__uint_as_float(c1[q]<<16)-lam*__uint_as_float(v[q]<<16); d1[2*q+1]=__uint_as_float(c1[q]&0xffff0000u)-lam*__uint_as_float(v[q]&0xffff0000u);
        ss+=d0[2*q]*d0[2*q]+d0[2*q+1]*d0[2*q+1]+d1[2*q]*d1[2*q]+d1[2*q+1]*d1[2*q+1]; }
      ss+=__shfl_xor(ss,1); ss+=__shfl_xor(ss,2); ss+=__shfl_xor(ss,4);
      const float rn=rsqrtf(ss*(1.0f/128.0f)+1e-6f)*0.8f;
      u32x4 w0,w1;
      #pragma unroll
      for(int q=0;q<4;++q){ w0[q]=cvtpk_s(d0[2*q]*rn,d0[2*q+1]*rn); w1[q]=cvtpk_s(d1[2*q]*rn,d1[2*q+1]*rn); }
      *(u32x4*)(Mw+(long)row*OP+ch*8)=w0; *(u32x4*)(Mw+(long)row*OP+64+ch*8)=w1; }
    } }
  }
  asm volatile("s_waitcnt lgkmcnt(0)\n\ts_barrier":::"memory");
  #undef DMA_K
  #undef DMA_V
  #undef CMASK
  #undef START
  #undef RESC
  #undef ROT
  return sl_next;
}
constexpr int ATTN_LDS_BYTES=LDS_BYTES;
#undef SBAR
#undef WAIT_BAR
}

namespace pg8 {
constexpr int MPc = 32768;
__device__ __forceinline__ float silu_f(float x) { return x * __builtin_amdgcn_rcpf(1.0f + __builtin_amdgcn_exp2f(-1.4426950408889634f * x)); }
struct EpiSwiGLU {
    static constexpr bool PERM = true, AFTER_DRAIN = false;
    unsigned char* O; int ldc; float inv, oscale;
    __device__ __forceinline__ void operator()(const f32x4 (&acc)[2][2][4][2], const Unit& u, int wr, int wc, int fr, int fq) const {
        const int row0 = u.pm * BM + wr * 64 + fr, col0 = u.pn * HALF + wc * 32 + 8 * fq;
#pragma unroll
        for (int ai = 0; ai < 2; ++ai)
#pragma unroll
            for (int m = 0; m < 4; ++m) { unsigned char* rowp = O + (size_t)(row0 + ai * HALF + m * 16) * ldc + col0;
                const f32x4 g0 = acc[ai][0][m][0] * inv, g1 = acc[ai][0][m][1] * inv, u0 = acc[ai][1][m][0] * (inv * oscale), u1 = acc[ai][1][m][1] * (inv * oscale);
                unsigned w0 = pk4_fp8(silu_f(g0[0]) * u0[0], silu_f(g0[1]) * u0[1], silu_f(g0[2]) * u0[2], silu_f(g0[3]) * u0[3]);
                unsigned w1 = pk4_fp8(silu_f(g1[0]) * u1[0], silu_f(g1[1]) * u1[1], silu_f(g1[2]) * u1[2], silu_f(g1[3]) * u1[3]);
                typedef unsigned u32x2_t __attribute__((ext_vector_type(2))); *(u32x2_t*)rowp = (u32x2_t){w0, w1}; }
    }
};
struct EpiResid {
    static constexpr bool PERM = true, AFTER_DRAIN = false;
    const float* baseP; const float* baseS; float* out; const float* gate; float s;
    __device__ __forceinline__ void operator()(const f32x4 (&acc)[2][2][4][2], const Unit& u, int wr, int wc, int fr, int fq) const {
        const int colb = u.pn * BM + wc * 32 + 8 * fq;
#pragma unroll
        for (int ai = 0; ai < 2; ++ai) {
            const int r0 = u.pm * BM + ai * HALF + wr * 64; const int mb = r0 < MPc ? (r0 >> 12) : 8 + ((r0 - MPc) >> 6);
            f32x4 gv[2][2];
#pragma unroll
            for (int bj = 0; bj < 2; ++bj)
#pragma unroll
                for (int n = 0; n < 2; ++n) gv[bj][n] = *(const f32x4*)(gate + (size_t)mb * 9216 + colb + bj * HALF + 4 * n) * s;
#pragma unroll
            for (int m = 0; m < 4; ++m) { const int row = r0 + m * 16 + fr;
                const float* bp = row < MPc ? baseP + (size_t)row * 1024 : baseS + (size_t)(row - MPc) * 1024; float* op = out + (size_t)row * 1024;
#pragma unroll
                for (int bj = 0; bj < 2; ++bj)
#pragma unroll
                    for (int n = 0; n < 2; ++n) { const int col = colb + bj * HALF + 4 * n; const f32x4 o = *(const f32x4*)(bp + col) + gv[bj][n] * acc[ai][bj][m][n]; *(f32x4*)(op + col) = o; }
            }
        }
    }
};
__device__ __forceinline__ void route_in(unsigned char* ws, float* out, float qscale, int row, int c, f32x4 v0, f32x4 v1) {
    const int pn = c >> 8; const bool smp = row >= MPc; const int sb = (row - MPc) >> 6, ts = row & 63;
    if (pn >= 6 && pn < 8) { v0 = v0 * qscale; v1 = v1 * qscale; }
    u32x4 w; w.x = cvt_pk_bf16(v0[0], v0[1]); w.y = cvt_pk_bf16(v0[2], v0[3]); w.z = cvt_pk_bf16(v1[0], v1[1]); w.w = cvt_pk_bf16(v1[2], v1[3]);
    if (pn < 2) { *(u32x4*)((bf16_t*)(ws + WS_Z) + (size_t)row * 512 + c) = w; }
    else if (pn < 6) { const int cc = c - 512; *(u32x4*)((bf16_t*)(ws + WS_XBC) + (size_t)row * 1024 + cc) = w;
        if (!smp) { const int tt = row & 4095; if (tt >= 4093) { float* p = out + O_CONVP + (size_t)((row >> 12) * 3 + tt - 4093) * 1024 + cc; *(f32x4*)p = v0; *(f32x4*)(p + 4) = v1; } }
        else if (ts >= 61) { float* p = out + O_CONVS + (size_t)(sb * 3 + ts - 61) * 1024 + cc; *(f32x4*)p = v0; *(f32x4*)(p + 4) = v1; } }
    else if (pn < 8) { const int cc = c - 1536; const size_t qrow = smp ? (size_t)(MPc + sb * 256 + ts) : (size_t)row; *(u32x4*)((bf16_t*)(ws + WS_Q) + qrow * 512 + cc) = w; }
    else { const bool isk = pn < 10; const int cc = c - (isk ? 2048 : 2560);
        bf16_t* bp = smp ? (bf16_t*)(ws + (isk ? WS_KS : WS_VS)) + (size_t)(sb * 2176 + 2048 + ts) * 512 + cc : (bf16_t*)(ws + (isk ? WS_K : WS_V)) + (size_t)row * 512 + cc;
        *(u32x4*)bp = w;
        float* fp = smp ? out + (isk ? O_NKS : O_NVS) + (size_t)(row - MPc) * 512 + cc : out + (isk ? O_NKP : O_NVP) + (size_t)row * 512 + cc;
        *(f32x4*)fp = v0; *(f32x4*)(fp + 4) = v1; }
}
struct EpiIn {
    static constexpr bool PERM = true, AFTER_DRAIN = false;
    unsigned char* ws; float* out; float qscale;
    __device__ __forceinline__ void operator()(const f32x4 (&acc)[2][2][4][2], const Unit& u, int wr, int wc, int fr, int fq) const {
        const int colt = u.pn * BM + wc * 32 + 8 * fq;
#pragma unroll
        for (int ai = 0; ai < 2; ++ai)
#pragma unroll
            for (int m = 0; m < 4; ++m) { const int row = u.pm * BM + ai * HALF + wr * 64 + m * 16 + fr;
#pragma unroll
                for (int bj = 0; bj < 2; ++bj) route_in(ws, out, qscale, row, colt + bj * HALF, acc[ai][bj][m][0], acc[ai][bj][m][1]); }
    }
};
struct EpiSlab {
    static constexpr bool PERM = true, AFTER_DRAIN = false;
    bf16_t* slab; int N; int kchunk;
    __device__ __forceinline__ void operator()(const f32x4 (&acc)[2][2][4][2], const Unit& u, int wr, int wc, int fr, int fq) const {
        bf16_t* base = slab + (size_t)(u.kofs / kchunk) * 512 * N; const int colb = u.pn * BM + wc * 32 + 8 * fq;
#pragma unroll
        for (int ai = 0; ai < 2; ++ai)
#pragma unroll
            for (int m = 0; m < 4; ++m) { bf16_t* rp = base + (size_t)(u.pm * BM - MPc + ai * HALF + wr * 64 + m * 16 + fr) * N + colb;
#pragma unroll
                for (int bj = 0; bj < 2; ++bj) { const f32x4 a0 = acc[ai][bj][m][0], a1 = acc[ai][bj][m][1];
                    u32x4 w; w.x = cvt_pk_bf16(a0[0], a0[1]); w.y = cvt_pk_bf16(a0[2], a0[3]); w.z = cvt_pk_bf16(a1[0], a1[1]); w.w = cvt_pk_bf16(a1[2], a1[3]);
                    *(u32x4*)(rp + bj * HALF) = w; } }
    }
};
template <bool BASE_BF16> struct EpiResidB {
    static constexpr bool PERM = true, AFTER_DRAIN = false;
    const void* base; bf16_t* out; const float* gate; float s;
    __device__ __forceinline__ void operator()(const f32x4 (&acc)[2][2][4][2], const Unit& u, int wr, int wc, int fr, int fq) const {
        const int colb = u.pn * BM + wc * 32 + 8 * fq;
#pragma unroll
        for (int ai = 0; ai < 2; ++ai) {
            const int r0 = u.pm * BM + ai * HALF + wr * 64; const int mb = r0 >> 12;
            f32x4 gv[2][2];
#pragma unroll
            for (int bj = 0; bj < 2; ++bj)
#pragma unroll
                for (int n = 0; n < 2; ++n) gv[bj][n] = *(const f32x4*)(gate + (size_t)mb * 9216 + colb + bj * HALF + 4 * n) * s;
#pragma unroll
            for (int m = 0; m < 4; ++m) { const size_t ro = (size_t)(r0 + m * 16 + fr) * 1024;
#pragma unroll
                for (int bj = 0; bj < 2; ++bj) { const int col = colb + bj * HALF; f32x4 b0, b1;
                    if (BASE_BF16) { const u32x4 raw = *(const u32x4*)((const bf16_t*)base + ro + col);
                        b0 = (f32x4){__uint_as_float(raw.x << 16), __uint_as_float(raw.x & 0xffff0000u), __uint_as_float(raw.y << 16), __uint_as_float(raw.y & 0xffff0000u)};
                        b1 = (f32x4){__uint_as_float(raw.z << 16), __uint_as_float(raw.z & 0xffff0000u), __uint_as_float(raw.w << 16), __uint_as_float(raw.w & 0xffff0000u)}; }
                    else { b0 = *(const f32x4*)((const float*)base + ro + col); b1 = *(const f32x4*)((const float*)base + ro + col + 4); }
                    const f32x4 o0 = b0 + gv[bj][0] * acc[ai][bj][m][0], o1 = b1 + gv[bj][1] * acc[ai][bj][m][1];
                    u32x4 w; w.x = cvt_pk_bf16(o0[0], o0[1]); w.y = cvt_pk_bf16(o0[2], o0[3]); w.z = cvt_pk_bf16(o1[0], o1[1]); w.w = cvt_pk_bf16(o1[2], o1[3]);
                    *(u32x4*)(out + ro + col) = w; }
            }
        }
    }
};
struct EpiResidAtomic {
    static constexpr bool PERM = true, AFTER_DRAIN = false;
    float* out; const float* gate; float s;
    __device__ __forceinline__ void operator()(const f32x4 (&acc)[2][2][4][2], const Unit& u, int wr, int wc, int fr, int fq) const {
        const int colb = u.pn * BM + wc * 32 + 8 * fq;
#pragma unroll
        for (int ai = 0; ai < 2; ++ai) {
            const int r0 = u.pm * BM + ai * HALF + wr * 64; const int mb = r0 < MPc ? (r0 >> 12) : 8 + ((r0 - MPc) >> 6);
            f32x4 gv[2][2];
#pragma unroll
            for (int bj = 0; bj < 2; ++bj)
#pragma unroll
                for (int n = 0; n < 2; ++n) gv[bj][n] = *(const f32x4*)(gate + (size_t)mb * 9216 + colb + bj * HALF + 4 * n) * s;
#pragma unroll
            for (int m = 0; m < 4; ++m) { float* op = out + (size_t)(r0 + m * 16 + fr) * 1024 + colb;
#pragma unroll
                for (int bj = 0; bj < 2; ++bj)
#pragma unroll
                    for (int n = 0; n < 2; ++n) { const f32x4 o = gv[bj][n] * acc[ai][bj][m][n]; float* p = op + bj * HALF + 4 * n;
                        unsafeAtomicAdd(p, o[0]); unsafeAtomicAdd(p + 1, o[1]); unsafeAtomicAdd(p + 2, o[2]); unsafeAtomicAdd(p + 3, o[3]); }
            }
        }
    }
};
}

namespace cg = cooperative_groups;
#define GAS __attribute__((address_space(1)))
#define LAS __attribute__((address_space(3)))
typedef unsigned short bf16;
typedef unsigned v4u __attribute__((ext_vector_type(4)));
typedef unsigned v2u __attribute__((ext_vector_type(2)));
typedef float f32x4 __attribute__((ext_vector_type(4)));
typedef short bf16x8 __attribute__((ext_vector_type(8)));
__device__ __forceinline__ float bf2f(unsigned x) { return __uint_as_float(x << 16); }
__device__ __forceinline__ float bflo(unsigned x) { return __uint_as_float(x << 16); }
__device__ __forceinline__ float bfhi(unsigned x) { return __uint_as_float(x & 0xffff0000u); }
__device__ __forceinline__ unsigned pk2(float lo, float hi) { return pg8::cvt_pk_bf16(lo, hi); }
__device__ __forceinline__ float silu_f(float x) { return x * __builtin_amdgcn_rcpf(1.0f + __builtin_amdgcn_exp2f(-1.4426950408889634f * x)); }
__device__ __forceinline__ float wave_sum(float v) {
#pragma unroll
    for (int o = 1; o < 64; o <<= 1) v += __shfl_xor(v, o);
    return v;
}
__device__ __forceinline__ float wave_incl_scan(float a, int lane) {
#pragma unroll
    for (int o = 1; o < 64; o <<= 1) { const float t = __shfl_up(a, o); if (lane >= o) a += t; }
    return a;
}
#define LDS_WAIT() asm volatile("s_waitcnt lgkmcnt(0)" ::: "memory")

__device__ __forceinline__ void ph_mod(const float* cp, const float* cs, const float* w_ada, const float* b_ada, float* MOD, float* MISC,
                                       const float* lq1, const float* lk1, const float* lq2, const float* lk2, LAS unsigned char* lds, int G, int tid) {
    asm volatile("" : "+v"(tid));
    LAS float* scT = (LAS float*)lds;
    LAS float* red = (LAS float*)(lds + 65536);
    const int lane = tid & 63, wave = tid >> 6;
    if ((int)blockIdx.x < 144) for (int i = tid; i < 16384; i += 512) { const int b = i >> 10, k = i & 1023; const float c = b < 8 ? cp[b * 1024 + k] : cs[(b - 8) * 1024 + k]; scT[k * 16 + b] = c / (1.0f + __expf(-c)); }
    __syncthreads();
    for (int unit = blockIdx.x; unit < 144; unit += G) {
        const int col = unit * 64 + lane;
        float acc[16];
#pragma unroll
        for (int b = 0; b < 16; ++b) acc[b] = 0.f;
        const int k0 = wave * 128;
#pragma unroll 16
        for (int kk = 0; kk < 128; ++kk) { const int k = k0 + kk; const float wv = w_ada[(size_t)k * 9216 + col];
            const f32x4 s0 = *(const LAS f32x4*)(scT + k * 16), s1 = *(const LAS f32x4*)(scT + k * 16 + 4), s2 = *(const LAS f32x4*)(scT + k * 16 + 8), s3 = *(const LAS f32x4*)(scT + k * 16 + 12);
            acc[0] += s0[0] * wv; acc[1] += s0[1] * wv; acc[2] += s0[2] * wv; acc[3] += s0[3] * wv; acc[4] += s1[0] * wv; acc[5] += s1[1] * wv; acc[6] += s1[2] * wv; acc[7] += s1[3] * wv;
            acc[8] += s2[0] * wv; acc[9] += s2[1] * wv; acc[10] += s2[2] * wv; acc[11] += s2[3] * wv; acc[12] += s3[0] * wv; acc[13] += s3[1] * wv; acc[14] += s3[2] * wv; acc[15] += s3[3] * wv; }
#pragma unroll
        for (int b = 0; b < 16; ++b) red[(wave * 16 + b) * 64 + lane] = acc[b];
        __syncthreads();
        for (int o = tid; o < 1024; o += 512) { const int b = o >> 6, l = o & 63; float s = 0.f;
#pragma unroll
            for (int w = 0; w < 8; ++w) s += red[(w * 16 + b) * 64 + l];
            MOD[(size_t)b * 9216 + unit * 64 + l] = s + b_ada[unit * 64 + l]; }
        __syncthreads();
    }
    if (blockIdx.x == (unsigned)(G - 1) && wave == 0) { float a = lq1[lane] * lk1[lane], b = lq2[lane] * lk2[lane]; a = wave_sum(a); b = wave_sum(b); if (lane == 0) MISC[0] = __expf(a) - __expf(b) + 0.2f; }
}

template <int MODE> __device__ __forceinline__ int rowmap(int n) {
    if (MODE == 1) { const int f = n < DFF ? n : n - DFF, u = n < DFF ? 0 : 128; return (f >> 7) * 256 + u + (f & 127); }
    if (MODE == 2) { return n < 1536 ? n : (n < 1544 ? -1 : n - 8); }
    return n;
}
template <int MODE, bool F8> __device__ __forceinline__ void transpose_item(const float* W, int K, int N, bf16* WT, LAS float* scr, int item, int lane, float sc) {
    const int nblk = (N + 31) / 32, kb = item / nblk, nb = item % nblk, k0 = 64 * kb, n0 = 32 * nb;
    const int nq = 4 * (lane & 7), nn = n0 + nq;
    f32x4 tv[8];
#pragma unroll
    for (int i = 0; i < 8; ++i) { const int kk = 8 * i + (lane >> 3); tv[i] = nn < N ? *(const f32x4*)(W + (size_t)(k0 + kk) * N + nn) : (f32x4){0.f, 0.f, 0.f, 0.f}; }
#pragma unroll
    for (int i = 0; i < 8; ++i) { const int kk = 8 * i + (lane >> 3); LAS float* d = scr + kk * 33 + nq; d[0] = tv[i][0]; d[1] = tv[i][1]; d[2] = tv[i][2]; d[3] = tv[i][3]; }
    LDS_WAIT(); asm volatile("" ::: "memory");
    const int c = lane & 7;
#pragma unroll
    for (int j = 0; j < 4; ++j) { const int n = (lane >> 3) + 8 * j; const LAS float* s = scr + (8 * c) * 33 + n;
        v4u o; o.x = pk2(s[0 * 33], s[1 * 33]); o.y = pk2(s[2 * 33], s[3 * 33]); o.z = pk2(s[4 * 33], s[5 * 33]); o.w = pk2(s[6 * 33], s[7 * 33]);
        const int r = (n0 + n < N) ? rowmap<MODE>(n0 + n) : -1;
        if (F8) { v2u o8; o8.x = pk4_fp8(s[0 * 33] * sc, s[1 * 33] * sc, s[2 * 33] * sc, s[3 * 33] * sc); o8.y = pk4_fp8(s[4 * 33] * sc, s[5 * 33] * sc, s[6 * 33] * sc, s[7 * 33] * sc);
            if (r >= 0) *(v2u*)((unsigned char*)WT + (size_t)r * K + k0 + 8 * c) = o8; }
        else if (r >= 0) *(v4u*)(WT + (size_t)r * K + k0 + 8 * c) = o; }
    LDS_WAIT(); asm volatile("" ::: "memory");
}

__device__ __forceinline__ void load_row4(const void* base, bool is_bf16, size_t row, int lane, f32x4 (&v)[4]) {
    if (is_bf16) { const v2u* p = (const v2u*)((const bf16*)base + row * DM);
#pragma unroll
        for (int j = 0; j < 4; ++j) { const v2u r = p[lane + 64 * j]; v[j] = (f32x4){bflo(r.x), bfhi(r.x), bflo(r.y), bfhi(r.y)}; } }
    else { const f32x4* p = (const f32x4*)((const float*)base + row * DM);
#pragma unroll
        for (int j = 0; j < 4; ++j) v[j] = p[lane + 64 * j]; }
}
template <bool WITH_DT, bool OUT8> __device__ __forceinline__ void norm_mod_rows(const void* xp, bool pb16, const void* xs, bool sb16, const float* w, const float* MOD, int ish, int isc, bf16* H,
                                                                        int vcu, int G, int tid, const LAS float* sW, const float* dt_bias, float* DT,
                                                                        const bf16* fslab, int fS, const float* fgate, float fsc, bf16* fxout) {
    asm volatile("" : "+v"(tid)); const int lane = tid & 63, gw = vcu * NWAVES + __builtin_amdgcn_readfirstlane(tid >> 6), NGW = G * NWAVES;
    f32x4 wv[4];
#pragma unroll
    for (int j = 0; j < 4; ++j) wv[j] = ((const f32x4*)w)[lane + 64 * j];
    f32x4 wdt[WITH_DT ? 8 : 1][4];
    if (WITH_DT) {
#pragma unroll
        for (int c = 0; c < 8; ++c)
#pragma unroll
            for (int j = 0; j < 4; ++j) wdt[c][j] = *(const LAS f32x4*)(sW + c * 1024 + 4 * (lane + 64 * j)); }
    f32x4 vn[4];
    if (gw < MT) { if (gw < MP) load_row4(xp, pb16, (size_t)gw, lane, vn); else load_row4(xs, sb16, (size_t)(gw - MP), lane, vn); }
    for (int row = gw; row < MT; row += NGW) {
        const int mb = row < MP ? (row >> 12) : 8 + ((row - MP) >> 6);
        f32x4 v[4]; float s = 0.f;
#pragma unroll
        for (int j = 0; j < 4; ++j) v[j] = vn[j];
        { const int rn = row + NGW; if (rn < MT) { if (rn < MP) load_row4(xp, pb16, (size_t)rn, lane, vn); else load_row4(xs, sb16, (size_t)(rn - MP), lane, vn); } }
        if (fslab && row >= MP) {
            f32x4 a[4];
#pragma unroll
            for (int j = 0; j < 4; ++j) a[j] = (f32x4){0.f, 0.f, 0.f, 0.f};
            for (int ks = 0; ks < fS; ++ks) { const v2u* sp = (const v2u*)(fslab + ((size_t)ks * MS + (row - MP)) * DM);
#pragma unroll
                for (int j = 0; j < 4; ++j) { const v2u r = sp[lane + 64 * j]; a[j] += (f32x4){bflo(r.x), bfhi(r.x), bflo(r.y), bfhi(r.y)}; } }
#pragma unroll
            for (int j = 0; j < 4; ++j) { v[j] += ((const f32x4*)(fgate + (size_t)mb * 9216))[lane + 64 * j] * fsc * a[j];
                v2u o; o.x = pk2(v[j][0], v[j][1]); o.y = pk2(v[j][2], v[j][3]); *(v2u*)(fxout + (size_t)row * DM + 4 * (lane + 64 * j)) = o; }
        }
#pragma unroll
        for (int j = 0; j < 4; ++j) s += (v[j][0] * v[j][0] + v[j][1] * v[j][1]) + (v[j][2] * v[j][2] + v[j][3] * v[j][3]);
        const float rstd = rsqrtf(wave_sum(s) * (1.0f / DM) + EPSN);
        const f32x4* sh = (const f32x4*)(MOD + (size_t)mb * 9216 + ish * 1024); const f32x4* sc = (const f32x4*)(MOD + (size_t)mb * 9216 + isc * 1024);
#pragma unroll
        for (int j = 0; j < 4; ++j) { const f32x4 a = v[j] * rstd * wv[j]; v[j] = a * (sc[lane + 64 * j] + 1.0f) + sh[lane + 64 * j];
            if (OUT8) { *(unsigned*)((unsigned char*)H + (size_t)row * DM + 4 * (lane + 64 * j)) = pk4_fp8(v[j][0] * SC_H8, v[j][1] * SC_H8, v[j][2] * SC_H8, v[j][3] * SC_H8); }
            else { v2u o; o.x = pk2(v[j][0], v[j][1]); o.y = pk2(v[j][2], v[j][3]); *(v2u*)(H + (size_t)row * DM + 4 * (lane + 64 * j)) = o; } }
        if (WITH_DT) {
            float d[8];
#pragma unroll
            for (int c = 0; c < 8; ++c) { float p = 0.f;
#pragma unroll
                for (int j = 0; j < 4; ++j) { const f32x4 ww = wdt[WITH_DT ? c : 0][j]; p += (v[j][0] * ww[0] + v[j][1] * ww[1]) + (v[j][2] * ww[2] + v[j][3] * ww[3]); }
                d[c] = p; }
            float e4[4], e2[2], e1;
            { const bool up = (lane & 32) != 0;
#pragma unroll
              for (int c = 0; c < 4; ++c) { const float keep = up ? d[4 + c] : d[c], give = up ? d[c] : d[4 + c]; e4[c] = keep + __shfl_xor(give, 32); } }
            { const bool up = (lane & 16) != 0;
#pragma unroll
              for (int c = 0; c < 2; ++c) { const float keep = up ? e4[2 + c] : e4[c], give = up ? e4[c] : e4[2 + c]; e2[c] = keep + __shfl_xor(give, 16); } }
            { const bool up = (lane & 8) != 0; const float keep = up ? e2[1] : e2[0], give = up ? e2[0] : e2[1]; e1 = keep + __shfl_xor(give, 8); }
            e1 += __shfl_xor(e1, 4); e1 += __shfl_xor(e1, 2); e1 += __shfl_xor(e1, 1);
            const int col = ((lane >> 5) & 1) * 4 + ((lane >> 4) & 1) * 2 + ((lane >> 3) & 1);
            if ((lane & 7) == 0) { const float p = e1 + dt_bias[col]; DT[(size_t)row * 8 + col] = fmaxf(p, 0.f) + log1pf(__expf(-fabsf(p))); }
        }
    }
}

__device__ __forceinline__ void ph_conv(const bf16* XBC, const float* state_conv, const float* conv_w, const float* conv_b, bf16* XT, bf16* BN, bf16* CN, bf16* BT, int c_lo, int c_hi, int vcu, int G, int tid) {
    asm volatile("" : "+v"(tid));
    const int ch = 2 * tid;
    float w0[4], w1[4];
#pragma unroll
    for (int w = 0; w < 4; ++w) { w0[w] = conv_w[w * 1024 + ch]; w1[w] = conv_w[w * 1024 + ch + 1]; }
    const float b0 = conv_b[ch], b1 = conv_b[ch + 1];
#define CONV_LD(itx, dst) do { const int r0_ = ((itx) >> 2) * 64 + ((itx) & 3) * 16; _Pragma("unroll") for (int i = 0; i < 19; ++i) { const int rr_ = r0_ - 3 + i; \
        dst[i] = *(const unsigned*)(XBC + (size_t)(rr_ < 0 ? 0 : rr_) * 1024 + ch); } } while (0)
    unsigned rawn[19];
    if (4 * c_lo + vcu < 4 * c_hi) CONV_LD(4 * c_lo + vcu, rawn);
    for (int it = 4 * c_lo + vcu; it < 4 * c_hi; it += G) {
        const int ci = it >> 2, q = it & 3, row0 = ci * 64 + q * 16; const bool smp = ci >= 512;
        unsigned raw[19];
#pragma unroll
        for (int i = 0; i < 19; ++i) raw[i] = rawn[i];
        if (it + G < 4 * c_hi) CONV_LD(it + G, rawn);
        float p0[3], p1[3];
        if (q == 0 && smp) {
#pragma unroll
            for (int i = 0; i < 3; ++i) { p0[i] = state_conv[(size_t)((ci - 512) * 3 + i) * 1024 + ch]; p1[i] = state_conv[(size_t)((ci - 512) * 3 + i) * 1024 + ch + 1]; }
        } else if (q == 0 && (ci & 63) == 0) {
#pragma unroll
            for (int i = 0; i < 3; ++i) { p0[i] = 0.f; p1[i] = 0.f; }
        } else {
#pragma unroll
            for (int i = 0; i < 3; ++i) { p0[i] = bflo(raw[i]); p1[i] = bfhi(raw[i]); }
        }
#pragma unroll
        for (int t8 = 0; t8 < 2; ++t8) {
            float y0[8], y1[8];
#pragma unroll
            for (int i = 0; i < 8; ++i) { const float x0 = bflo(raw[3 + t8 * 8 + i]), x1 = bfhi(raw[3 + t8 * 8 + i]);
                const float a0 = b0 + w0[0] * p0[0] + w0[1] * p0[1] + w0[2] * p0[2] + w0[3] * x0, a1 = b1 + w1[0] * p1[0] + w1[1] * p1[1] + w1[2] * p1[2] + w1[3] * x1;
                y0[i] = silu_f(a0); y1[i] = silu_f(a1); p0[0] = p0[1]; p0[1] = p0[2]; p0[2] = x0; p1[0] = p1[1]; p1[1] = p1[2]; p1[2] = x1; }
            v4u t0, t1; t0.x = pk2(y0[0], y0[1]); t0.y = pk2(y0[2], y0[3]); t0.z = pk2(y0[4], y0[5]); t0.w = pk2(y0[6], y0[7]);
            t1.x = pk2(y1[0], y1[1]); t1.y = pk2(y1[2], y1[3]); t1.z = pk2(y1[4], y1[5]); t1.w = pk2(y1[6], y1[7]);
            const int tl = q * 16 + t8 * 8;
            if (tid < 256) { const int h = ch >> 6, p = ch & 63; bf16* d = XT + ((size_t)(ci * 8 + h) * 64 + p) * 64 + tl; *(v4u*)d = t0; *(v4u*)(d + 64) = t1; }
            else if (tid < 384) { const int cb = ch - 512, g = cb >> 7, n = cb & 127;
#pragma unroll
                for (int i = 0; i < 8; ++i) *(unsigned*)(BN + (size_t)(row0 + t8 * 8 + i) * 256 + cb) = pk2(y0[i], y1[i]);
                bf16* d = BT + ((size_t)(ci * 2 + g) * 128 + n) * 64 + tl; *(v4u*)d = t0; *(v4u*)(d + 64) = t1; }
            else { const int cc = ch - 768;
#pragma unroll
                for (int i = 0; i < 8; ++i) *(unsigned*)(CN + (size_t)(row0 + t8 * 8 + i) * 256 + cc) = pk2(y0[i], y1[i]); }
        }
    }
}

#undef CONV_LD
__device__ __forceinline__ void ph_ssd_scan(const float* DT, const bf16* XT, const bf16* BT, bf16* HST, const float* state_ssm, const float* a_log, float* ssm_p, float* ssm_s, LAS unsigned char* lds, int vcu, int G, int tid) {
    asm volatile("" : "+v"(tid)); const int lane = tid & 63, wave = __builtin_amdgcn_readfirstlane(tid >> 6);
    const int fr = lane & 15, fq = lane >> 4;
    for (int it = vcu; it < 512; it += G) {
        const bool smp = it >= 256; const int id = it & 255, b = id >> 5, h = (id >> 2) & 7, pq = id & 3, g = h >> 2;
        const float A = -__expf(a_log[h]);
        const int p = pq * 16 + fr, n0 = 16 * wave + 4 * fq;
        f32x4 hst = (f32x4){0.f, 0.f, 0.f, 0.f};
        if (smp) hst = *(const f32x4*)(state_ssm + ((size_t)(b * 8 + h) * 64 + p) * 128 + n0);
        const int nch = smp ? 1 : 64, ci0 = smp ? 512 + b : b * 64;
        LAS float* sWg = (LAS float*)lds;
        LAS float* sDec = (LAS float*)(lds + 16384);
        __syncthreads();
        for (int c = wave; c < nch; c += NWAVES) { const float dtv = DT[(size_t)((ci0 + c) * 64 + lane) * 8 + h]; const float a = wave_incl_scan(dtv * A, lane); const float tot = __shfl(a, 63);
            sWg[c * 64 + lane] = dtv * __expf(tot - a); if (lane == 0) sDec[c] = __expf(tot); }
        __syncthreads();
        if (!smp) {
        LAS unsigned char* sX = lds + 32768;
        bf16x8 br[8][2];
#define SCAN_LD(u, cc) do { const int cl_ = ci0 + (cc); _Pragma("unroll") for (int ks = 0; ks < 2; ++ks) \
            br[u][ks] = *(const bf16x8*)(BT + ((size_t)(cl_ * 2 + g) * 128 + 16 * wave + fr) * 64 + 32 * ks + 8 * fq); } while (0)
#pragma unroll
        for (int u = 0; u < 8; ++u) SCAN_LD(u, u);
        for (int half = 0; half < 2; ++half) {
            __syncthreads();
            { bf16x8 xq[4][2];
#pragma unroll
              for (int i = 0; i < 4; ++i) { const int cq = ci0 + 32 * half + wave + 8 * i;
#pragma unroll
                  for (int ks = 0; ks < 2; ++ks) xq[i][ks] = *(const bf16x8*)(XT + ((size_t)(cq * 8 + h) * 64 + p) * 64 + 32 * ks + 8 * fq); }
#pragma unroll
              for (int i = 0; i < 4; ++i) { const int cl = wave + 8 * i, c = 32 * half + cl;
#pragma unroll
                  for (int ks = 0; ks < 2; ++ks) { const v4u xw = __builtin_bit_cast(v4u, xq[i][ks]); v4u o;
                      const f32x4 w0 = *(const LAS f32x4*)(sWg + c * 64 + 32 * ks + 8 * fq), w1 = *(const LAS f32x4*)(sWg + c * 64 + 32 * ks + 8 * fq + 4);
                      o[0] = pk2(bflo(xw[0]) * w0[0], bfhi(xw[0]) * w0[1]); o[1] = pk2(bflo(xw[1]) * w0[2], bfhi(xw[1]) * w0[3]); o[2] = pk2(bflo(xw[2]) * w1[0], bfhi(xw[2]) * w1[1]); o[3] = pk2(bflo(xw[3]) * w1[2], bfhi(xw[3]) * w1[3]);
                      *(LAS v4u*)(sX + (cl * 16 + fr) * 144 + 64 * ks + 16 * fq) = o; } } }
            __syncthreads();
            for (int c0 = 32 * half; c0 < 32 * half + 32; c0 += 8) {
#pragma unroll
                for (int u = 0; u < 8; ++u) { const int c = c0 + u, ci = ci0 + c, cl = c - 32 * half;
                    f32x4 st = (f32x4){0.f, 0.f, 0.f, 0.f};
#pragma unroll
                    for (int ks = 0; ks < 2; ++ks) { const bf16x8 xa = *(const LAS bf16x8*)(sX + (cl * 16 + fr) * 144 + 64 * ks + 16 * fq);
                        st = __builtin_amdgcn_mfma_f32_16x16x32_bf16(br[u][ks], xa, st, 0, 0, 0); }
                    { const int cn = (c + 8 < 64) ? c + 8 : 63; SCAN_LD(u, cn); }
                    v2u hs; hs.x = pk2(hst[0], hst[1]); hs.y = pk2(hst[2], hst[3]);
                    *(v2u*)(HST + ((size_t)(ci * 8 + h) * 64 + p) * 128 + n0) = hs;
                    hst = hst * sDec[c] + st; }
            }
        }
#undef SCAN_LD
        } else {
        bf16x8 xa_n[2], bb_n[2];
#pragma unroll
        for (int ks = 0; ks < 2; ++ks) { xa_n[ks] = *(const bf16x8*)(XT + ((size_t)(ci0 * 8 + h) * 64 + p) * 64 + 32 * ks + 8 * fq); bb_n[ks] = *(const bf16x8*)(BT + ((size_t)(ci0 * 2 + g) * 128 + 16 * wave + fr) * 64 + 32 * ks + 8 * fq); }
        for (int c = 0; c < nch; ++c) {
            const int ci = ci0 + c;
            bf16x8 xa[2], bb[2];
#pragma unroll
            for (int ks = 0; ks < 2; ++ks) { xa[ks] = xa_n[ks]; bb[ks] = bb_n[ks]; }
            if (c + 1 < nch) { const int cn = ci + 1;
#pragma unroll
                for (int ks = 0; ks < 2; ++ks) { xa_n[ks] = *(const bf16x8*)(XT + ((size_t)(cn * 8 + h) * 64 + p) * 64 + 32 * ks + 8 * fq); bb_n[ks] = *(const bf16x8*)(BT + ((size_t)(cn * 2 + g) * 128 + 16 * wave + fr) * 64 + 32 * ks + 8 * fq); } }
            f32x4 st = (f32x4){0.f, 0.f, 0.f, 0.f};
#pragma unroll
            for (int ks = 0; ks < 2; ++ks) { const v4u xw = __builtin_bit_cast(v4u, xa[ks]); v4u o;
                const f32x4 w0 = *(const LAS f32x4*)(sWg + c * 64 + 32 * ks + 8 * fq), w1 = *(const LAS f32x4*)(sWg + c * 64 + 32 * ks + 8 * fq + 4);
                o[0] = pk2(bflo(xw[0]) * w0[0], bfhi(xw[0]) * w0[1]); o[1] = pk2(bflo(xw[1]) * w0[2], bfhi(xw[1]) * w0[3]); o[2] = pk2(bflo(xw[2]) * w1[0], bfhi(xw[2]) * w1[1]); o[3] = pk2(bflo(xw[3]) * w1[2], bfhi(xw[3]) * w1[3]);
                st = __builtin_amdgcn_mfma_f32_16x16x32_bf16(bb[ks], __builtin_bit_cast(bf16x8, o), st, 0, 0, 0); }
            v2u hs; hs.x = pk2(hst[0], hst[1]); hs.y = pk2(hst[2], hst[3]);
            *(v2u*)(HST + ((size_t)(ci * 8 + h) * 64 + p) * 128 + n0) = hs;
            hst = hst * sDec[c] + st;
        }
        }
        float* dst = smp ? ssm_s : ssm_p;
        *(f32x4*)(dst + ((size_t)(b * 8 + h) * 64 + p) * 128 + n0) = hst;
    }
}

template <int NMT> __device__ __forceinline__ void ssd_out_item(const int ci, const int mt0, const float* DT, const bf16* XT, const bf16* BN, const bf16* CN, const bf16* HST, const bf16* Z, const float* ssd_norm,
                                                                bf16* MIXA, LAS unsigned char* lds, const float A, const float Dh, const int lane, const int wave) {
    LAS float* sCB = (LAS float*)lds;
    LAS float* sAcs = (LAS float*)(lds + 34816);
    LAS float* sDt = (LAS float*)(lds + 36864);
    LAS float* sSS = (LAS float*)(lds + 38912);
    const int h = wave, g = h >> 2, fr = lane & 15, fq = lane >> 4;
        const int row0 = ci * 64;
        { const float dtv = DT[(size_t)(row0 + lane) * 8 + h]; const float a = wave_incl_scan(dtv * A, lane); sAcs[h * 64 + lane] = a; sDt[h * 64 + lane] = dtv; }
        if (NMT == 4 || (wave & 3) == 0) { const int mt = 0, mt0c = (NMT == 4) ? (wave & 3) : mt0; bf16x8 cf[4];
#pragma unroll
          for (int ks = 0; ks < 4; ++ks) cf[ks] = *(const bf16x8*)(CN + (size_t)(row0 + 16 * mt0c + fr) * 256 + g * 128 + 32 * ks + 8 * fq);
#pragma unroll
          for (int st = 0; st < 4; ++st) { f32x4 acc = (f32x4){0.f, 0.f, 0.f, 0.f};
#pragma unroll
              for (int ks = 0; ks < 4; ++ks) { const bf16x8 bfv = *(const bf16x8*)(BN + (size_t)(row0 + 16 * st + fr) * 256 + g * 128 + 32 * ks + 8 * fq); acc = __builtin_amdgcn_mfma_f32_16x16x32_bf16(bfv, cf[ks], acc, 0, 0, 0); }
              *(LAS f32x4*)(sCB + (g * 64 + 16 * mt0c + fr) * 68 + 16 * st + 4 * fq) = acc; } }
        __syncthreads();
        f32x4 acc[4][NMT];
#pragma unroll
        for (int nt = 0; nt < 4; ++nt)
#pragma unroll
            for (int mt = 0; mt < NMT; ++mt) acc[nt][mt] = (f32x4){0.f, 0.f, 0.f, 0.f};
#pragma unroll
        for (int ks = 0; ks < 2; ++ks) {
            bf16x8 xf[4];
#pragma unroll
            for (int nt = 0; nt < 4; ++nt) xf[nt] = *(const bf16x8*)(XT + ((size_t)(ci * 8 + h) * 64 + 16 * nt + fr) * 64 + 32 * ks + 8 * fq);
            const int s0 = 32 * ks + 8 * fq;
            const f32x4 as0 = *(const LAS f32x4*)(sAcs + h * 64 + s0), as1 = *(const LAS f32x4*)(sAcs + h * 64 + s0 + 4), d0 = *(const LAS f32x4*)(sDt + h * 64 + s0), d1 = *(const LAS f32x4*)(sDt + h * 64 + s0 + 4);
#pragma unroll
            for (int mt = 0; mt < NMT; ++mt) { const int l = 16 * (mt0 + mt) + fr; const float al = sAcs[h * 64 + l];
                const f32x4 c0 = *(const LAS f32x4*)(sCB + (g * 64 + l) * 68 + s0), c1 = *(const LAS f32x4*)(sCB + (g * 64 + l) * 68 + s0 + 4);
                float mv[8];
#pragma unroll
                for (int j = 0; j < 4; ++j) { mv[j] = (s0 + j <= l) ? c0[j] * __expf(fminf(al - as0[j], 0.f)) * d0[j] : 0.f; mv[4 + j] = (s0 + 4 + j <= l) ? c1[j] * __expf(fminf(al - as1[j], 0.f)) * d1[j] : 0.f; }
#pragma unroll
                for (int j = 0; j < 8; ++j) if (s0 + j == l) mv[j] += Dh;
                v4u mw; mw.x = pk2(mv[0], mv[1]); mw.y = pk2(mv[2], mv[3]); mw.z = pk2(mv[4], mv[5]); mw.w = pk2(mv[6], mv[7]);
                const bf16x8 mf = __builtin_bit_cast(bf16x8, mw);
#pragma unroll
                for (int nt = 0; nt < 4; ++nt) acc[nt][mt] = __builtin_amdgcn_mfma_f32_16x16x32_bf16(xf[nt], mf, acc[nt][mt], 0, 0, 0); }
        }
#pragma unroll
        for (int ks = 0; ks < 4; ++ks) {
            bf16x8 hf[4];
#pragma unroll
            for (int nt = 0; nt < 4; ++nt) hf[nt] = *(const bf16x8*)(HST + ((size_t)(ci * 8 + h) * 64 + 16 * nt + fr) * 128 + 32 * ks + 8 * fq);
#pragma unroll
            for (int mt = 0; mt < NMT; ++mt) { const int l = 16 * (mt0 + mt) + fr; const float e = __expf(sAcs[h * 64 + l]);
                const v4u cw = *(const v4u*)(CN + (size_t)(row0 + l) * 256 + g * 128 + 32 * ks + 8 * fq); v4u o;
#pragma unroll
                for (int j = 0; j < 4; ++j) o[j] = pk2(bflo(cw[j]) * e, bfhi(cw[j]) * e);
                const bf16x8 cs = __builtin_bit_cast(bf16x8, o);
#pragma unroll
                for (int nt = 0; nt < 4; ++nt) acc[nt][mt] = __builtin_amdgcn_mfma_f32_16x16x32_bf16(hf[nt], cs, acc[nt][mt], 0, 0, 0); }
        }
#pragma unroll
        for (int mt = 0; mt < NMT; ++mt) { float ss = 0.f;
#pragma unroll
            for (int nt = 0; nt < 4; ++nt) { const v2u zr = *(const v2u*)(Z + (size_t)(row0 + 16 * (mt0 + mt) + fr) * 512 + h * 64 + 16 * nt + 4 * fq);
                f32x4 y = acc[nt][mt]; y[0] *= silu_f(bflo(zr.x)); y[1] *= silu_f(bfhi(zr.x)); y[2] *= silu_f(bflo(zr.y)); y[3] *= silu_f(bfhi(zr.y)); acc[nt][mt] = y;
                ss += (y[0] * y[0] + y[1] * y[1]) + (y[2] * y[2] + y[3] * y[3]); }
            ss += __shfl_xor(ss, 16); ss += __shfl_xor(ss, 32);
            if (fq == 0) sSS[h * 64 + 16 * (mt0 + mt) + fr] = ss; }
        __syncthreads();
#pragma unroll
        for (int mt = 0; mt < NMT; ++mt) { const int l = 16 * (mt0 + mt) + fr; float tot = 0.f;
#pragma unroll
            for (int w = 0; w < 8; ++w) tot += sSS[w * 64 + l];
            const float rstd = rsqrtf(tot * (1.0f / 512.0f) + EPSN);
#pragma unroll
            for (int nt = 0; nt < 4; ++nt) { const f32x4 nw = *(const f32x4*)(ssd_norm + h * 64 + 16 * nt + 4 * fq); const f32x4 o = acc[nt][mt] * rstd * nw;
                v2u ow; ow.x = pk2(o[0], o[1]); ow.y = pk2(o[2], o[3]); *(v2u*)(MIXA + (size_t)(row0 + l) * 1024 + h * 64 + 16 * nt + 4 * fq) = ow; } }
        __syncthreads();
}
__device__ __forceinline__ void ph_ssd_out(const float* DT, const bf16* XT, const bf16* BN, const bf16* CN, const bf16* HST, const bf16* Z, const float* a_log, const float* d_skip, const float* ssd_norm,
                                           bf16* MIXA, LAS unsigned char* lds, int vcu, int G, int tid) {
    asm volatile("" : "+v"(tid)); const int lane = tid & 63, wave = __builtin_amdgcn_readfirstlane(tid >> 6);
    const float A = -__expf(a_log[wave]), Dh = d_skip[wave];
    for (int ci = vcu; ci < 512; ci += G) ssd_out_item<4>(ci, 0, DT, XT, BN, CN, HST, Z, ssd_norm, MIXA, lds, A, Dh, lane, wave);
    for (int it = vcu; it < 32; it += G) ssd_out_item<1>(512 + (it >> 2), it & 3, DT, XT, BN, CN, HST, Z, ssd_norm, MIXA, lds, A, Dh, lane, wave);
}

__device__ __forceinline__ void ph_combine(const bf16* ATTO, const bf16* ATTOS, const float* MISC, bf16* MIXA, int vcu, int G, int tid, int row_lo) {
    asm volatile("" : "+v"(tid)); const int lane = tid & 63, gw = vcu * NWAVES + __builtin_amdgcn_readfirstlane(tid >> 6), NGW = G * NWAVES;
    const float lam = MISC[0];
    const int hh = lane >> 4, e0 = (lane & 15) * 8;
    v4u an = (v4u){0u, 0u, 0u, 0u}, bn = an;
    const int gs = row_lo + gw;
    if (gs < MT) { const bf16* orow = gs < MP ? ATTO + (size_t)gs * 1024 : ATTOS + (size_t)(((gs - MP) >> 6) * 256 + (gs & 63)) * 1024; an = *(const v4u*)(orow + (hh * 2) * 128 + e0); bn = *(const v4u*)(orow + (hh * 2 + 1) * 128 + e0); }
    for (int row = gs; row < MT; row += NGW) {
        const v4u a = an, b = bn;
        { const int rn = row + NGW; if (rn < MT) { const bf16* orow = rn < MP ? ATTO + (size_t)rn * 1024 : ATTOS + (size_t)(((rn - MP) >> 6) * 256 + (rn & 63)) * 1024; an = *(const v4u*)(orow + (hh * 2) * 128 + e0); bn = *(const v4u*)(orow + (hh * 2 + 1) * 128 + e0); } }
        float o[8]; float ss = 0.f;
#pragma unroll
        for (int j = 0; j < 4; ++j) { o[2 * j] = bflo(a[j]) - lam * bflo(b[j]); o[2 * j + 1] = bfhi(a[j]) - lam * bfhi(b[j]); ss += o[2 * j] * o[2 * j] + o[2 * j + 1] * o[2 * j + 1]; }
        ss += __shfl_xor(ss, 1); ss += __shfl_xor(ss, 2); ss += __shfl_xor(ss, 4); ss += __shfl_xor(ss, 8);
        const float r = rsqrtf(ss * (1.0f / 128.0f) + EPSN) * 0.8f;
        v4u w; w.x = pk2(o[0] * r, o[1] * r); w.y = pk2(o[2] * r, o[3] * r); w.z = pk2(o[4] * r, o[5] * r); w.w = pk2(o[6] * r, o[7] * r);
        *(v4u*)(MIXA + (size_t)row * 1024 + 512 + hh * 128 + e0) = w;
    }
}

__device__ __forceinline__ void ph_final(const bf16* X3, float* Y, const float* w, int vcu, int G, int tid, const bf16* fslab, int fS, const float* fgate, float fsc) {
    asm volatile("" : "+v"(tid)); const int lane = tid & 63, gw = vcu * NWAVES + __builtin_amdgcn_readfirstlane(tid >> 6), NGW = G * NWAVES;
    f32x4 wv[4];
#pragma unroll
    for (int j = 0; j < 4; ++j) wv[j] = ((const f32x4*)w)[lane + 64 * j];
    f32x4 vn[4];
    if (gw < MT) load_row4(X3, true, (size_t)gw, lane, vn);
    for (int row = gw; row < MT; row += NGW) {
        f32x4 v[4]; float s = 0.f;
#pragma unroll
        for (int j = 0; j < 4; ++j) v[j] = vn[j];
        if (row + NGW < MT) load_row4(X3, true, (size_t)(row + NGW), lane, vn);
        if (row >= MP) { const int mb = 8 + ((row - MP) >> 6);
            f32x4 a[4];
#pragma unroll
            for (int j = 0; j < 4; ++j) a[j] = (f32x4){0.f, 0.f, 0.f, 0.f};
            for (int ks = 0; ks < fS; ++ks) { const v2u* sp = (const v2u*)(fslab + ((size_t)ks * MS + (row - MP)) * DM);
#pragma unroll
                for (int j = 0; j < 4; ++j) { const v2u r = sp[lane + 64 * j]; a[j] += (f32x4){bflo(r.x), bfhi(r.x), bflo(r.y), bfhi(r.y)}; } }
#pragma unroll
            for (int j = 0; j < 4; ++j) v[j] += ((const f32x4*)(fgate + (size_t)mb * 9216))[lane + 64 * j] * fsc * a[j];
        }
#pragma unroll
        for (int j = 0; j < 4; ++j) s += (v[j][0] * v[j][0] + v[j][1] * v[j][1]) + (v[j][2] * v[j][2] + v[j][3] * v[j][3]);
        const float rstd = rsqrtf(wave_sum(s) * (1.0f / DM) + EPSN);
        f32x4* yr = (f32x4*)(Y + (size_t)row * DM);
#pragma unroll
        for (int j = 0; j < 4; ++j) yr[lane + 64 * j] = v[j] * rstd * wv[j];
    }
}

__device__ __forceinline__ int opq(int v) { asm volatile("" : "+s"(v)); return v; }
__device__ __forceinline__ void finish_gu(const bf16* slab, unsigned char* ACT8, int vcu, int G, int tid) {
    asm volatile("" : "+v"(tid)); const int gt = vcu * 512 + tid, NT_ = G * 512;
    for (int i = gt; i < 512 * 704; i += NT_) { const int r = i / 704, f = (i - r * 704) * 4, c = (f >> 7) * 256 + (f & 127);
        f32x4 g = (f32x4){0.f, 0.f, 0.f, 0.f}, u = g;
#pragma unroll
        for (int ks = 0; ks < 2; ++ks) { const bf16* p = slab + ((size_t)ks * 512 + r) * NGU + c; const v2u gr = *(const v2u*)p, ur = *(const v2u*)(p + 128);
            g += (f32x4){bflo(gr.x), bfhi(gr.x), bflo(gr.y), bfhi(gr.y)}; u += (f32x4){bflo(ur.x), bfhi(ur.x), bflo(ur.y), bfhi(ur.y)}; }
        g = g * INV_GU; u = u * (INV_GU * SC_ACT8);
        *(unsigned*)(ACT8 + (size_t)(MP + r) * DFF + f) = pk4_fp8(silu_f(g[0]) * u[0], silu_f(g[1]) * u[1], silu_f(g[2]) * u[2], silu_f(g[3]) * u[3]); }
}
__device__ __forceinline__ void finish_in(const bf16* slab, unsigned char* ws, float* out, float qscale, int vcu, int G, int tid) {
    asm volatile("" : "+v"(tid)); const int gt = vcu * 512 + tid, NT_ = G * 512;
    for (int i = gt; i < 512 * 384; i += NT_) { const int r = i / 384, c = (i - r * 384) * 8;
        f32x4 v0 = (f32x4){0.f, 0.f, 0.f, 0.f}, v1 = v0;
#pragma unroll
        for (int ks = 0; ks < 4; ++ks) { const v4u r4 = *(const v4u*)(slab + ((size_t)ks * 512 + r) * NIN + c); v0 += (f32x4){bflo(r4.x), bfhi(r4.x), bflo(r4.y), bfhi(r4.y)}; v1 += (f32x4){bflo(r4.z), bfhi(r4.z), bflo(r4.w), bfhi(r4.w)}; }
        pg8::route_in(ws, out, qscale, MP + r, c, v0, v1); }
}
__device__ __forceinline__ void flag_arrive(unsigned* cnt, int tid) {
    asm volatile("s_waitcnt vmcnt(0)" ::: "memory"); __syncthreads();
    if (tid == 0) { __builtin_amdgcn_fence(__ATOMIC_RELEASE, "agent"); asm volatile("s_waitcnt vmcnt(0)" ::: "memory"); (void)__hip_atomic_fetch_add(cnt, 1u, __ATOMIC_RELAXED, __HIP_MEMORY_SCOPE_AGENT); }
}
__device__ __forceinline__ void flag_wait(unsigned* cnt, unsigned want, int tid) {
    if (tid == 0) { unsigned sp = 0; while (__hip_atomic_load(cnt, __ATOMIC_RELAXED, __HIP_MEMORY_SCOPE_AGENT) < want) { __builtin_amdgcn_s_sleep(2); if (++sp > (1u << 22)) break; }
        __builtin_amdgcn_fence(__ATOMIC_ACQUIRE, "agent"); asm volatile("s_waitcnt vmcnt(0)" ::: "memory"); }
    __syncthreads();
}

#define XB_TMO      128
#define XB_XCNT(j)  (256  + 64 * (j))
#define XB_XSUB(j)  (1280 + 64 * (j))
#define XB_XGEN(j)  (2304 + 64 * (j))
#define XB_TOP      3328
#define XB_TOPGEN   3392
#define XCD_BAR_WORDS 3456
#define XB_SPIN_CAP (1u << 18)

__device__ __forceinline__ unsigned xb_ld(unsigned* p)              { return __hip_atomic_load(p, __ATOMIC_RELAXED, __HIP_MEMORY_SCOPE_AGENT); }
__device__ __forceinline__ unsigned xb_add(unsigned* p, unsigned v) { return __hip_atomic_fetch_add(p, v, __ATOMIC_RELAXED, __HIP_MEMORY_SCOPE_AGENT); }
__device__ __forceinline__ unsigned xb_xcc_id() { return (unsigned)__builtin_amdgcn_s_getreg((3 << 11) | 20) & 0xFu; }
#define XB_SPIN(cond, bar) do { unsigned _sp = 0; while (cond) { __builtin_amdgcn_s_sleep(1); \
    if ((++_sp & 255u) == 0u) { if (xb_ld(&(bar)[XB_TMO])) break; if (_sp > XB_SPIN_CAP) { atomicAdd(&(bar)[XB_TMO], 1u); break; } } } } while (0)

struct XcdBarrier {
    unsigned* bar; unsigned x;
    volatile LAS unsigned* st;
};

__device__ __forceinline__ XcdBarrier xcd_barrier_post(unsigned* bar, volatile LAS unsigned* st) {
    XcdBarrier b; b.bar = bar; b.x = xb_xcc_id(); b.st = st;
    if (threadIdx.x == 0) (void)xb_add(&bar[XB_XCNT(b.x)], 1u);
    return b;
}
__device__ __forceinline__ void xcd_barrier_complete(unsigned* bar, unsigned x, unsigned& nloc, unsigned& nx) {
    const unsigned G = gridDim.x * gridDim.y * gridDim.z;
    unsigned sum, cnt, mine, sp = 0u;
    for (;;) {
        sum = 0u; cnt = 0u; mine = 0u;
#pragma unroll
        for (unsigned j = 0; j < 16; ++j) { const unsigned c = xb_ld(&bar[XB_XCNT(j)]); sum += c; cnt += (c > 0u) ? 1u : 0u; mine = (j == x) ? c : mine; }
        if (sum == G) break;
        __builtin_amdgcn_s_sleep(1);
        if ((++sp & 255u) == 0u) { if (xb_ld(&bar[XB_TMO])) break; if (sp > XB_SPIN_CAP) { atomicAdd(&bar[XB_TMO], 1u); break; } }
    }
    nloc = mine > 0u ? mine : 1u; nx = cnt > 0u ? cnt : 1u;
}

__device__ __forceinline__ void xcd_barrier(const XcdBarrier& b) {
    asm volatile("s_waitcnt vmcnt(0)" ::: "memory");
    __syncthreads();
    if (threadIdx.x == 0) {
        unsigned* bar = b.bar;
        __builtin_amdgcn_s_waitcnt(0);
        unsigned nloc = b.st[0], nx = b.st[1];
        if (nloc == 0u) { xcd_barrier_complete(bar, b.x, nloc, nx); b.st[0] = nloc; b.st[1] = nx; }
        const unsigned old = xb_add(&bar[XB_XSUB(b.x)], 1u);
        const unsigned gen = old / nloc;
        if (old + 1u == (gen + 1u) * nloc) {
            __builtin_amdgcn_fence(__ATOMIC_RELEASE, "agent");
            asm volatile("s_waitcnt vmcnt(0)" ::: "memory");
            const unsigned og = xb_add(&bar[XB_TOP], 1u);
            const unsigned tg = og / nx;
            if (og + 1u == (tg + 1u) * nx) xb_add(&bar[XB_TOPGEN], 1u);
            else XB_SPIN(xb_ld(&bar[XB_TOPGEN]) == tg, bar);
            __builtin_amdgcn_fence(__ATOMIC_ACQUIRE, "agent");
            xb_add(&bar[XB_XGEN(b.x)], 1u);
            asm volatile("s_waitcnt vmcnt(0)" ::: "memory");
        } else {
            XB_SPIN(xb_ld(&bar[XB_XGEN(b.x)]) == gen, bar);
            __builtin_amdgcn_fence(__ATOMIC_ACQUIRE, "agent");
            asm volatile("s_waitcnt vmcnt(0)" ::: "memory");
        }
    }
    __syncthreads();
}

template <int I> __device__ __forceinline__ const float* karg_in() {
    unsigned long long v;
    asm volatile("s_load_dwordx2 %0, %1, %2\n\ts_waitcnt lgkmcnt(0)" : "=s"(v) : "s"(__builtin_amdgcn_kernarg_segment_ptr()), "n"(I * 8) : "memory");
    return (const float*)v;
}
struct Args { const float* in[30]; float* out; unsigned char* ws; int ph_lo, ph_hi, coop, pad; };
__global__ void __launch_bounds__(NWAVES * 64, 2) mk_fwd(Args args) {
    extern __shared__ __attribute__((aligned(16))) unsigned char lds[];
    LAS unsigned char* L = (LAS unsigned char*)lds;
    const int tid = threadIdx.x;
    const int G = gridDim.x, bx = blockIdx.x; const int vcu = (G % 8 == 0) ? (bx % 8) * (G / 8) + bx / 8 : bx;
    unsigned char* ws = args.ws; float* out = args.out;
#define MOD ((float*)(ws + WS_MOD))
#define MISC ((float*)(ws + WS_MISC))
#define DT ((float*)(ws + WS_DT))
#define Wgu1 ((bf16*)(ws + WS_WGU1))
#define Wd1 ((bf16*)(ws + WS_WD1))
#define Win ((bf16*)(ws + WS_WIN))
#define Wout ((bf16*)(ws + WS_WOUT))
#define Wgu2 ((bf16*)(ws + WS_WGU2))
#define Wd2 ((bf16*)(ws + WS_WD2))
#define H ((bf16*)(ws + WS_H))
#define ACT ((bf16*)(ws + WS_ACT))
#define XBC ((bf16*)(ws + WS_XBC))
#define Zb ((bf16*)(ws + WS_Z))
#define Qb ((bf16*)(ws + WS_Q))
#define Kb ((bf16*)(ws + WS_K))
#define Vb ((bf16*)(ws + WS_V))
#define KS ((bf16*)(ws + WS_KS))
#define VS ((bf16*)(ws + WS_VS))
#define XT ((bf16*)(ws + WS_XT))
#define BN ((bf16*)(ws + WS_BN))
#define CN ((bf16*)(ws + WS_CN))
#define BT ((bf16*)(ws + WS_BT))
#define HST ((bf16*)(ws + WS_HST))
#define ATTO ((bf16*)(ws + WS_ATTO))
#define ATTOS ((bf16*)(ws + WS_ATTOS))
#define XB ((bf16*)out)
#define X3 ((bf16*)(ws + WS_H))
    const int lo = args.ph_lo, hi = args.ph_hi;
    volatile LAS unsigned* LCTL = (volatile LAS unsigned*)(L + 131072);
    if (tid < 64) LCTL[tid] = 0u;
    __syncthreads();
    XcdBarrier bar; bar.bar = (unsigned*)(ws + WS_CTL) + 4096; bar.x = 0; bar.st = nullptr;
    if (args.coop) bar = xcd_barrier_post((unsigned*)(ws + WS_CTL) + 4096, LCTL + 8);
#define IN(k) (lo <= (k) && (k) < hi)
#define CNT(i) ((unsigned*)(ws + WS_CTL) + 8192 + 64 * (i))
#ifndef REP_MASK
#define REP_MASK 0
#endif
#define REPS(k) (((REP_MASK >> (k)) & 1) ? 2 : 1)
#define SEAM(k) do { if (IN(k) && IN((k) + 1)) { xcd_barrier(bar); } } while (0)

    if (IN(0)) for (int rep_ = 0; rep_ < REPS(0); ++rep_) { ph_mod(karg_in<6>(), karg_in<7>(), karg_in<8>(), karg_in<9>(), MOD, MISC, karg_in<21>(), karg_in<22>(), karg_in<23>(), karg_in<24>(), L, G, tid); flag_arrive(CNT(3), tid); }
    if (args.coop == 2) cg::this_grid().sync();
    if (IN(1)) for (int rep_ = 0; rep_ < REPS(1); ++rep_) {
        int t1 = tid; asm volatile("" : "+v"(t1)); const int lane = t1 & 63, wave = __builtin_amdgcn_readfirstlane(t1 >> 6), gw = vcu * NWAVES + wave, NGW = G * NWAVES;
        LAS float* scr = (LAS float*)(L + wave * 16384);
        constexpr int I_GU = (DM / 64) * (NGU / 32), I_D = (DFF / 64) * (DM / 32), I_IN = (DM / 64) * ((INC + 31) / 32), I_O = (DM / 64) * (DM / 32);
        constexpr int NITEMS = 2 * I_GU + 2 * I_D + I_IN + I_O;
        for (int it = gw; it < NITEMS; it += NGW) { int r = it;
            if (r < I_GU) { transpose_item<1, true>(karg_in<11>(), DM, NGU, Wgu1, scr, r, lane, SC_WGU8); continue; } r -= I_GU;
            if (r < I_GU) { transpose_item<1, true>(karg_in<27>(), DM, NGU, Wgu2, scr, r, lane, SC_WGU8); continue; } r -= I_GU;
            if (r < I_D) { transpose_item<0, true>(karg_in<12>(), DFF, DM, Wd1, scr, r, lane, SC_WD8); continue; } r -= I_D;
            if (r < I_D) { transpose_item<0, true>(karg_in<28>(), DFF, DM, Wd2, scr, r, lane, SC_WD8); continue; } r -= I_D;
            if (r < I_IN) { transpose_item<2, false>(karg_in<14>(), DM, INC, Win, scr, r, lane, 1.0f); continue; } r -= I_IN;
            transpose_item<0, false>(karg_in<25>(), DM, DM, Wout, scr, r, lane, 1.0f);
        }
        { const float* ck = karg_in<2>(); const float* cv = karg_in<3>(); const int gt = vcu * 512 + tid, NT_ = G * 512;
          for (int i0 = gt; i0 < 8 * 2048 * 64; i0 += 2 * NT_) {
              f32x4 a0[2], a1[2], b0[2], b1[2]; size_t dofs[2];
#pragma unroll
              for (int u = 0; u < 2; ++u) { const int i = i0 + u * NT_; const int c8 = i & 63, t = (i >> 6) & 2047, sb = i >> 17; const size_t so = ((size_t)(sb * 2048 + t) * 512 + c8 * 8); dofs[u] = ((size_t)(sb * 2176 + t) * 512 + c8 * 8);
                  const bool ok = i < 8 * 2048 * 64; const size_t s2 = ok ? so : 0; if (!ok) dofs[u] = (size_t)-1;
                  a0[u] = *(const f32x4*)(ck + s2); a1[u] = *(const f32x4*)(ck + s2 + 4); b0[u] = *(const f32x4*)(cv + s2); b1[u] = *(const f32x4*)(cv + s2 + 4); }
#pragma unroll
              for (int u = 0; u < 2; ++u) if (dofs[u] != (size_t)-1) { v4u w; w.x = pk2(a0[u][0], a0[u][1]); w.y = pk2(a0[u][2], a0[u][3]); w.z = pk2(a1[u][0], a1[u][1]); w.w = pk2(a1[u][2], a1[u][3]); *(v4u*)(KS + dofs[u]) = w;
                  w.x = pk2(b0[u][0], b0[u][1]); w.y = pk2(b0[u][2], b0[u][3]); w.z = pk2(b1[u][0], b1[u][1]); w.w = pk2(b1[u][2], b1[u][3]); *(v4u*)(VS + dofs[u]) = w; } }
          for (int i = gt; i < 8 * 64 * 64; i += NT_) { const int c8 = i & 63, t = (i >> 6) & 63, sb = i >> 12; const size_t dofs = ((size_t)(sb * 2176 + 2112 + t) * 512 + c8 * 8);
              *(v4u*)(KS + dofs) = (v4u){0u, 0u, 0u, 0u}; *(v4u*)(VS + dofs) = (v4u){0u, 0u, 0u, 0u}; } }
        flag_wait(CNT(3), (unsigned)G, tid);
        norm_mod_rows<false, true>(karg_in<0>(), false, karg_in<1>(), false, karg_in<10>(), MOD, 0, 1, H, vcu, G, tid, nullptr, nullptr, nullptr, nullptr, 0, nullptr, 0.f, nullptr);
    }
    SEAM(1);
    if (IN(2)) for (int rep_ = 0; rep_ < REPS(2); ++rep_) { { pg8::Gemm g{H, Wgu1, MP, NGU, DM / 2, DM / 2}; pg8::StaticOrder S; S.init(MP, NGU, G, bx); pg8::EpiSwiGLU E{(unsigned char*)ACT, DFF, INV_GU, SC_ACT8};
        pg8::gemm_phase<pg8::EpiSwiGLU, pg8::StaticOrder, true, true, true>(L, g, S, E); }
        { pg8::Gemm g{H, Wgu1, MS, NGU, opq(256), DM / 2}; pg8::SplitOrder S; S.init(2, NGU, 2, 256, MP / 256, G, vcu); pg8::EpiSlab E{(bf16*)(ws + WS_XT), NGU, 256};
        pg8::gemm_phase<pg8::EpiSlab, pg8::SplitOrder, true, true, true>(L, g, S, E); } }
    SEAM(2);
    if (IN(3)) for (int rep_ = 0; rep_ < REPS(3); ++rep_) { finish_gu((const bf16*)(ws + WS_XT), (unsigned char*)ACT, vcu, G, tid); flag_arrive(CNT(0), tid);
        { pg8::Gemm g{ACT, Wd1, MP, DM, DFF / 2, DFF / 2}; pg8::StaticOrder S; S.init(MP, DM, G, bx); pg8::EpiResidB<false> E{karg_in<0>(), XB, MOD + 2 * 1024, 0.5f * INV_D};
        pg8::gemm_phase<pg8::EpiResidB<false>, pg8::StaticOrder, true, true, true>(L, g, S, E); }
        flag_wait(CNT(0), (unsigned)G, tid);
        { pg8::Gemm g{ACT, Wd1, MS, DM, opq(128), DFF / 2}; pg8::SplitOrder S; S.init(2, DM, 11, 128, MP / 256, G, vcu); pg8::EpiSlab E{(bf16*)(ws + WS_HST), DM, 128};
        pg8::gemm_phase<pg8::EpiSlab, pg8::SplitOrder, true, true, true>(L, g, S, E); } }
    SEAM(3);
    if (IN(4)) for (int rep_ = 0; rep_ < REPS(4); ++rep_) {
        LAS float* sW = (LAS float*)L;
        for (int i = tid; i < 8192; i += 512) { const int c = i & 7, k = i >> 3; sW[c * 1024 + k] = karg_in<14>()[(size_t)k * INC + 1536 + c]; }
        __syncthreads();
        norm_mod_rows<true, false>(XB, true, karg_in<1>(), false, karg_in<13>(), MOD, 3, 4, H, vcu, G, tid, sW, karg_in<17>(), DT, (const bf16*)(ws + WS_HST), 11, MOD + 2 * 1024, 0.5f * INV_D, XB);
        __syncthreads();
    }
    SEAM(4);
    if (IN(5)) for (int rep_ = 0; rep_ < REPS(5); ++rep_) { { pg8::Gemm g{H, Win, MP, NIN, DM, DM}; pg8::StaticOrder S; S.init(MP, NIN, G, bx);
        pg8::EpiIn E{ws, out, 0.125f * 1.4426950408889634f};
        pg8::gemm_phase<pg8::EpiIn, pg8::StaticOrder, true, true>(L, g, S, E); }
        { pg8::Gemm g{H, Win, MS, NIN, opq(256), DM}; pg8::SplitOrder S; S.init(2, NIN, 4, 256, MP / 256, G, vcu); pg8::EpiSlab E{(bf16*)(ws + WS_HST), NIN, 256};
        pg8::gemm_phase<pg8::EpiSlab, pg8::SplitOrder, true, true>(L, g, S, E); } }
    SEAM(5);
    if (IN(6)) { finish_in((const bf16*)(ws + WS_HST), ws, out, 0.125f * 1.4426950408889634f, vcu, G, tid); flag_arrive(CNT(1), tid);
        ph_conv(XBC, karg_in<5>(), karg_in<15>(), karg_in<16>(), XT, BN, CN, BT, 0, 512, vcu, G, tid);
        flag_wait(CNT(1), (unsigned)G, tid);
        ph_conv(XBC, karg_in<5>(), karg_in<15>(), karg_in<16>(), XT, BN, CN, BT, 512, NCH, vcu, G, tid); }
    SEAM(6);
    if (IN(7)) for (int rep_ = 0; rep_ < REPS(7); ++rep_) { ph_ssd_scan(DT, XT, BT, HST, karg_in<4>(), karg_in<18>(), out + O_SSMP, out + O_SSMS, L, vcu, G, tid); }
    if (IN(7)) { __syncthreads();
        { const float lam = MISC[0];
        for (int v = vcu; v < 256; v += G) {
            const int bh = v >> 3, s = v & 7, b = bh >> 2, hd = bh & 3;
            int ring0 = 0; bool primed = false;
            for (int i = 0; i < 8; ++i) { const int qb = (i >> 2) ? 15 - s : s, j = (i >> 1) & 1, vh = i & 1;
                const bf16* Qp = Qb + (size_t)(b * 4096 + qb * 256) * 512 + (hd * 2 + j) * 64; const bf16* Kp = Kb + (size_t)(b * 4096) * 512 + (hd * 2 + j) * 64; const bf16* Vp = Vb + (size_t)(b * 4096) * 512 + (hd * 2 + vh) * 64;
                bf16* Op = ATTO + (size_t)(b * 4096 + qb * 256) * 1024 + ((hd * 2 + j) * 2 + vh) * 64;
                bf16* Mp = ((i & 3) == 3) ? H + (size_t)(b * 4096 + qb * 256) * 1024 + 512 + hd * 128 : nullptr;
                const bool more = i < 7; const int jn = ((i + 1) >> 1) & 1, vn = (i + 1) & 1;
                const bf16* nK = Kb + (size_t)(b * 4096) * 512 + (hd * 2 + jn) * 64; const bf16* nV = Vb + (size_t)(b * 4096) * 512 + (hd * 2 + vn) * 64;
                ring0 = attn_body::attn_unit<8, false>((const attn_body::bf16*)Qp, (const attn_body::bf16*)Kp, (const attn_body::bf16*)Vp, (attn_body::bf16*)Op, 4 * (qb + 1), -1, (char*)lds, ring0, primed,
                                                       more ? (const attn_body::bf16*)nK : nullptr, more ? (const attn_body::bf16*)nV : nullptr, (attn_body::bf16*)Mp, lam); primed = more; }
        } }
        for (int v = vcu; v < 128; v += G) {
            const int grp = v, vh = grp & 1, j = (grp >> 1) & 1, hd = (grp >> 2) & 3, sb = grp >> 4;
            const bf16* Qp = Qb + (size_t)(MP + sb * 256) * 512 + (hd * 2 + j) * 64; const bf16* Kp = KS + (size_t)(sb * 2176) * 512 + (hd * 2 + j) * 64; const bf16* Vp = VS + (size_t)(sb * 2176) * 512 + (hd * 2 + vh) * 64;
            bf16* Op = ATTOS + (size_t)(sb * 256) * 1024 + ((hd * 2 + j) * 2 + vh) * 64;
            attn_body::attn_unit<8, true>((const attn_body::bf16*)Qp, (const attn_body::bf16*)Kp, (const attn_body::bf16*)Vp, (attn_body::bf16*)Op, 34, 2, (char*)lds, 0, false, nullptr, nullptr, nullptr, 0.f);
        }
    }
    SEAM(7);
    if (IN(8)) for (int rep_ = 0; rep_ < REPS(8); ++rep_) { ph_ssd_out(DT, XT, BN, CN, HST, Zb, karg_in<18>(), karg_in<19>(), karg_in<20>(), H, L, vcu, G, tid); }
    if (IN(8)) { ph_combine(ATTO, ATTOS, MISC, H, vcu, G, tid, MP); }
    SEAM(8);
    if (IN(11)) { { pg8::Gemm g{H, Wout, MP, DM, DM, DM}; pg8::StaticOrder S; S.init(MP, DM, G, bx); pg8::EpiResidB<true> E{XB, XB, MOD + 5 * 1024, 1.0f};
        pg8::gemm_phase<pg8::EpiResidB<true>, pg8::StaticOrder, true, true>(L, g, S, E); }
        { pg8::Gemm g{H, Wout, MS, DM, opq(256), DM}; pg8::SplitOrder S; S.init(2, DM, 4, 256, MP / 256, G, vcu); pg8::EpiSlab E{(bf16*)(ws + WS_XT + 48 * MiB), DM, 256};
        pg8::gemm_phase<pg8::EpiSlab, pg8::SplitOrder, true, true>(L, g, S, E); } }
    SEAM(11);
    if (IN(12)) for (int rep_ = 0; rep_ < REPS(12); ++rep_) { norm_mod_rows<false, true>(XB, true, XB + (size_t)MP * DM, true, karg_in<26>(), MOD, 6, 7, H, vcu, G, tid, nullptr, nullptr, nullptr, (const bf16*)(ws + WS_XT + 48 * MiB), 4, MOD + 5 * 1024, 1.0f, X3); }
    SEAM(12);
    if (IN(13)) { { pg8::Gemm g{H, Wgu2, MP, NGU, DM / 2, DM / 2}; pg8::StaticOrder S; S.init(MP, NGU, G, bx); pg8::EpiSwiGLU E{(unsigned char*)ACT, DFF, INV_GU, SC_ACT8};
        pg8::gemm_phase<pg8::EpiSwiGLU, pg8::StaticOrder, true, true, true>(L, g, S, E); }
        { pg8::Gemm g{H, Wgu2, MS, NGU, opq(256), DM / 2}; pg8::SplitOrder S; S.init(2, NGU, 2, 256, MP / 256, G, vcu); pg8::EpiSlab E{(bf16*)(ws + WS_XT), NGU, 256};
        pg8::gemm_phase<pg8::EpiSlab, pg8::SplitOrder, true, true, true>(L, g, S, E); } }
    SEAM(13);
    if (IN(14)) { finish_gu((const bf16*)(ws + WS_XT), (unsigned char*)ACT, vcu, G, tid); flag_arrive(CNT(2), tid);
        { pg8::Gemm g{ACT, Wd2, MP, DM, DFF / 2, DFF / 2}; pg8::StaticOrder S; S.init(MP, DM, G, bx); pg8::EpiResidB<true> E{XB, X3, MOD + 8 * 1024, 0.5f * INV_D};
        pg8::gemm_phase<pg8::EpiResidB<true>, pg8::StaticOrder, true, true, true>(L, g, S, E); }
        flag_wait(CNT(2), (unsigned)G, tid);
        { pg8::Gemm g{ACT, Wd2, MS, DM, opq(128), DFF / 2}; pg8::SplitOrder S; S.init(2, DM, 11, 128, MP / 256, G, vcu); pg8::EpiSlab E{(bf16*)(ws + WS_HST), DM, 128};
        pg8::gemm_phase<pg8::EpiSlab, pg8::SplitOrder, true, true, true>(L, g, S, E); } }
    SEAM(14);
    if (IN(15)) { ph_final(X3, out, karg_in<29>(), vcu, G, tid, (const bf16*)(ws + WS_HST), 11, MOD + 8 * 1024, 0.5f * INV_D); }
#undef IN
#undef SEAM
}

#ifndef MK_PER_PHASE
#define MK_PER_PHASE 0
#endif
extern "C" void kernel_launch(void* const* d_in, const int* in_sizes, int n_in, void* d_out, int out_size, void* d_ws, size_t ws_size, hipStream_t stream) {
    static int grid = 0;
    if (grid == 0) {
        if (n_in != 30 || (size_t)out_size != O_TOTAL || ws_size < WS_END) { fprintf(stderr, "kernel_launch: unexpected shapes (n_in %d out %d ws %zu)\n", n_in, out_size, ws_size); grid = -1; return; }
        int dev = 0, cus = 0, per_cu = 0;
        if (hipGetDevice(&dev) != hipSuccess || hipDeviceGetAttribute(&cus, hipDeviceAttributeMultiprocessorCount, dev) != hipSuccess) { grid = -1; return; }
        if (hipFuncSetAttribute((const void*)mk_fwd, hipFuncAttributeMaxDynamicSharedMemorySize, LDS_BYTES) != hipSuccess) { fprintf(stderr, "kernel_launch: hipFuncSetAttribute failed\n"); grid = -1; return; }
        if (hipOccupancyMaxActiveBlocksPerMultiprocessor(&per_cu, (const void*)mk_fwd, NWAVES * 64, LDS_BYTES) != hipSuccess || per_cu < 1) { fprintf(stderr, "kernel_launch: occupancy query says %d\n", per_cu); per_cu = 1; }
        (void)hipGetLastError();
        grid = cus * 1;
    }
    if (grid < 0) return;
    Args a{};
    for (int i = 0; i < 30; ++i) a.in[i] = (const float*)d_in[i];
    a.out = (float*)d_out; a.ws = (unsigned char*)d_ws;
#if MK_PER_PHASE
    for (int ph = 0; ph < N_PHASES; ++ph) { a.ph_lo = ph; a.ph_hi = ph + 1; a.coop = 0;
        hipLaunchKernelGGL(mk_fwd, dim3(grid), dim3(NWAVES * 64), LDS_BYTES, stream, a); }
#else
    if (hipMemsetAsync((char*)d_ws + WS_CTL, 0, CTL_ZERO_BYTES, stream) != hipSuccess) { fprintf(stderr, "kernel_launch: memset failed\n"); return; }
    a.ph_lo = 0; a.ph_hi = N_PHASES; a.coop = 1;
    void* kargs[] = {&a};
    hipError_t e = hipLaunchCooperativeKernel((const void*)mk_fwd, dim3(grid), dim3(NWAVES * 64), kargs, LDS_BYTES, stream);
    if (e != hipSuccess) fprintf(stderr, "kernel_launch: cooperative launch failed: %s (grid %d)\n", hipGetErrorString(e), grid);
#endif
}
```

```cpp
#include <hip/hip_runtime.h>
#include <hip/hip_cooperative_groups.h>
#include <cstdio>
#include <cstdint>
constexpr int NWAVES = 8;
constexpr int DM = 1024, MP = 32768, MS = 512, MT = MP + MS, DFF = 2816, NGU = 2 * DFF, NIN = 3072, INC = 3080, NCH = 520;
constexpr float EPSN = 1e-6f;
constexpr int N_PHASES = 16;
constexpr size_t O_Y = 0, O_NKP = 34078720, O_NVP = 50855936, O_SSMP = 67633152, O_CONVP = 68157440, O_NKS = 68182016, O_NVS = 68444160, O_SSMS = 68706304, O_CONVS = 69230592, O_TOTAL = 69255168;
constexpr size_t MiB = 1u << 20;
constexpr size_t WS_CTL = 0, CTL_ZERO_BYTES = 64 * 1024;
constexpr size_t WS_MOD = 1 * MiB, WS_MISC = 1 * MiB + 640 * 1024, WS_DT = 2 * MiB;
constexpr size_t WS_WGU1 = 4 * MiB, WS_WD1 = 15 * MiB, WS_WIN = 21 * MiB, WS_WOUT = 27 * MiB, WS_WGU2 = 29 * MiB, WS_WD2 = 40 * MiB;
constexpr size_t WS_H = 46 * MiB, WS_ACT = 111 * MiB;
constexpr size_t WS_XBC = 111 * MiB, WS_Z = 176 * MiB, WS_Q = 209 * MiB, WS_K = 243 * MiB;
constexpr size_t WS_V = 290 * MiB, WS_KS = 322 * MiB, WS_VS = 339 * MiB, WS_XT = 356 * MiB, WS_BN = 389 * MiB, WS_CN = 406 * MiB, WS_BT = 423 * MiB, WS_HST = 440 * MiB;
constexpr size_t WS_ATTO = 111 * MiB  , WS_ATTOS = 505 * MiB, WS_END = 509 * MiB;
static_assert(WS_ACT + (size_t)MT * DFF * 2 <= WS_V && WS_K + (size_t)MP * 512 * 2 <= WS_V && WS_HST + (size_t)NCH * 8 * 64 * 128 * 2 <= WS_ATTOS, "ws map");
constexpr int LDS_BYTES = 147456;

constexpr float SC_H8 = 8.0f, SC_WGU8 = 64.0f, SC_ACT8 = 4.0f, SC_WD8 = 128.0f;
constexpr float INV_GU = 1.0f / (SC_H8 * SC_WGU8), INV_D = 1.0f / (SC_ACT8 * SC_WD8);
__device__ __forceinline__ float clamp8(float x) { return __builtin_amdgcn_fmed3f(x, -448.0f, 448.0f); }
__device__ __forceinline__ unsigned pk4_fp8(float a, float b, float c, float d) {
    int w = __builtin_amdgcn_cvt_pk_fp8_f32(clamp8(a), clamp8(b), 0, false); w = __builtin_amdgcn_cvt_pk_fp8_f32(clamp8(c), clamp8(d), w, true); return (unsigned)w; }
namespace pg8 {
#define PG8_LAS __attribute__((address_space(3)))
typedef unsigned short bf16_t;
typedef short bf16x8 __attribute__((ext_vector_type(8)));
typedef float f32x4 __attribute__((ext_vector_type(4)));
typedef unsigned u32x4 __attribute__((ext_vector_type(4)));
typedef int i32x4_t __attribute__((ext_vector_type(4)));
constexpr int BM = 256, BK = 64, HALF = 128, HTB = HALF * BK * 2  , STAGE_BYTES = 8 * HTB, NXCD = 8, WGM = 8;

__host__ __device__ __forceinline__ int lds_byte(int r, int c) { const int st = (r >> 4) * 2 + (c >> 5), rr = r & 15, cc = c & 31, ob = rr * 64 + cc * 2; return st * 1024 + (ob ^ (((ob >> 9) & 1) << 5)); }
__host__ __device__ __forceinline__ void stage_rc(int b, int& R, int& C) { const int st = b / 1024, sb = b % 1024, swz = sb ^ (((sb >> 9) & 1) << 5); R = (st >> 1) * 16 + swz / 64; C = (st & 1) * 32 + (swz % 64) / 2; }
__host__ __device__ __forceinline__ int perm32(int rho) { const int n = rho >> 4, i = rho & 15; return 8 * (i >> 2) + 4 * n + (i & 3); }

struct Unit { int pm, pn, kofs; };
struct Gemm { const bf16_t* A; const bf16_t* Bt; int M, N, K, ld; };

struct StaticOrder {
    int nM, nN, nwg, G, c;
    __host__ __device__ void init(int M, int N, int G_, int c_) { nM = M / BM; nN = N / BM; nwg = nM * nN; G = G_; c = c_; }
    __host__ __device__ bool next(int i, Unit& u) const {
        const long L = (long)i * G + c; if (L >= nwg) return false;
        int wgid = (int)L; { const int q = nwg / NXCD, r = nwg % NXCD, xcd = wgid % NXCD, off = wgid / NXCD; wgid = (xcd < r ? xcd * (q + 1) : r * (q + 1) + (xcd - r) * q) + off; }
        const int nig = WGM * nN, gid = wgid / nig, fm = gid * WGM, gsz = (nM - fm) < WGM ? (nM - fm) : WGM;
        u.pm = fm + ((wgid % nig) % gsz); u.pn = (wgid % nig) / gsz; u.kofs = 0; return true;
    }
    __device__ __forceinline__ void a_ready(const Unit&) const {}
    __device__ __forceinline__ void done(const Unit&) const {}
};

struct SplitOrder {
    int nN, S, kchunk, pm0, nunits, G, c;
    __host__ __device__ void init(int nM, int N, int S_, int kchunk_, int pm0_, int G_, int c_) { nN = N / BM; S = S_; kchunk = kchunk_; pm0 = pm0_; nunits = nM * nN * S_; G = G_; c = c_; }
    __host__ __device__ bool next(int i, Unit& u) const {
        const int L = i * G + c; if (L >= nunits) return false;
        const int ks = L % S, t = L / S; u.pn = t % nN; u.pm = pm0 + t / nN; u.kofs = ks * kchunk; return true;
    }
    __device__ __forceinline__ void a_ready(const Unit&) const {}
    __device__ __forceinline__ void done(const Unit&) const {}
};

__device__ __forceinline__ unsigned cvt_pk_bf16(float lo, float hi) { unsigned r; asm volatile("v_cvt_pk_bf16_f32 %0, %1, %2" : "=v"(r) : "v"(lo), "v"(hi)); return r; }
typedef float f32x2 __attribute__((ext_vector_type(2)));
__device__ __forceinline__ const char* uni_ptr(const char* p) { const unsigned long long v = (unsigned long long)p; const unsigned lo = __builtin_amdgcn_readfirstlane((unsigned)v), hi = __builtin_amdgcn_readfirstlane((unsigned)(v >> 32)); return (const char*)(((unsigned long long)hi << 32) | lo); }
__device__ __forceinline__ void glds_s(const char* sbase, unsigned voff, unsigned lds_dst) { unsigned keep;
    asm volatile("s_mov_b32 %0, m0\n\ts_mov_b32 m0, %3\n\ts_nop 0\n\tglobal_load_lds_dwordx4 %1, %2\n\ts_mov_b32 m0, %0" : "=&s"(keep) : "v"(voff), "s"(sbase), "s"(lds_dst) : "memory"); }
typedef int i32x8_t __attribute__((ext_vector_type(8)));
template <bool F8> struct FragT { typedef bf16x8 A[4][2]; typedef bf16x8 B[2][2]; };
template <> struct FragT<true> { typedef i32x8_t A[4]; typedef i32x8_t B[2]; };
template <class Epi, class Sched, bool ALIGN_EPI = false, bool SP2 = false, bool F8 = false>
__device__ __forceinline__ void gemm_phase(PG8_LAS unsigned char* lds, const Gemm g, const Sched& S, const Epi& E) {
    int tid_ = threadIdx.x; asm volatile("" : "+v"(tid_));
    const int tid = tid_, wid = __builtin_amdgcn_readfirstlane(tid >> 6), lane = tid & 63, wr = wid >> 2, wc = wid & 3, fr = lane & 15, fq = lane >> 4;
    const int K = g.K, nt = K / BK;
    unsigned voffA, voffB;
    { int R, C; stage_rc(tid * 16, R, C); const int Rb = Epi::PERM ? ((R & ~31) + perm32(R & 31)) : R;
        voffA = (unsigned)(R * g.ld + C) * 2u; voffB = (unsigned)(Rb * g.ld + C) * 2u; }
    const size_t pstep = (size_t)64 * g.ld * 2;
    const size_t kstep = (size_t)(BK * 2);
    const size_t hstep = (size_t)HALF * g.ld * 2;
    const size_t tstep = 2 * hstep;
    const unsigned ldsbase = (unsigned)(size_t)lds;
    const unsigned ldsw = (unsigned)wid * 1024u;
    const int aoff = lds_byte(wr * 64 + fr, fq * 8), boff = lds_byte(wc * 32 + fr, fq * 8);
#define PG8_SA(b, h) (((b) * 2 + (h)) * HTB)
#define PG8_SB(b, h) ((4 + (b) * 2 + (h)) * HTB)
#define PG8_STAGE(bufoff, gbase, voff) do { const char* gb0_ = uni_ptr((const char*)(gbase)); const char* gb1_ = uni_ptr((const char*)(gbase) + pstep);     \
        __builtin_amdgcn_global_load_lds((const unsigned*)(gb0_ + (voff)), (PG8_LAS unsigned*)(lds + (bufoff) + ldsw), 16, 0, 0); \
        __builtin_amdgcn_global_load_lds((const unsigned*)(gb1_ + (voff)), (PG8_LAS unsigned*)(lds + (bufoff) + ldsw + 8192), 16, 0, 0); } while (0)
#define PG8_CAT(lo, hi) __builtin_shufflevector(__builtin_bit_cast(i32x4_t, lo), __builtin_bit_cast(i32x4_t, hi), 0, 1, 2, 3, 4, 5, 6, 7)
#define PG8_LDA(dst, b, h) do { _Pragma("unroll") for (int m = 0; m < 4; ++m) { if constexpr (F8) { dst[m] = PG8_CAT(*(const PG8_LAS bf16x8*)(lds + PG8_SA(b, h) + aoff + m * 2048), *(const PG8_LAS bf16x8*)(lds + PG8_SA(b, h) + aoff + m * 2048 + 1024)); } \
        else { _Pragma("unroll") for (int k = 0; k < 2; ++k) dst[m][k] = *(const PG8_LAS bf16x8*)(lds + PG8_SA(b, h) + aoff + m * 2048 + k * 1024); } } } while (0)
#define PG8_LDB(dst, b, h) do { _Pragma("unroll") for (int n = 0; n < 2; ++n) { if constexpr (F8) { dst[n] = PG8_CAT(*(const PG8_LAS bf16x8*)(lds + PG8_SB(b, h) + boff + n * 2048), *(const PG8_LAS bf16x8*)(lds + PG8_SB(b, h) + boff + n * 2048 + 1024)); } \
        else { _Pragma("unroll") for (int k = 0; k < 2; ++k) dst[n][k] = *(const PG8_LAS bf16x8*)(lds + PG8_SB(b, h) + boff + n * 2048 + k * 1024); } } } while (0)
#define PG8_MMA(ai, bj, At, Bt) do { __builtin_amdgcn_s_setprio(1); _Pragma("unroll") for (int m = 0; m < 4; ++m) _Pragma("unroll") for (int n = 0; n < 2; ++n) { \
        if constexpr (F8) { acc[ai][bj][m][n] = __builtin_amdgcn_mfma_scale_f32_16x16x128_f8f6f4(Bt[n], At[m], acc[ai][bj][m][n], 0, 0, 0, 0x7F7F7F7F, 0, 0x7F7F7F7F); } \
        else { _Pragma("unroll") for (int k = 0; k < 2; ++k) acc[ai][bj][m][n] = __builtin_amdgcn_mfma_f32_16x16x32_bf16(Bt[n][k], At[m][k], acc[ai][bj][m][n], 0, 0, 0); } } __builtin_amdgcn_s_setprio(0); } while (0)
#define PG8_WAIT_V(n) asm volatile("s_waitcnt vmcnt(" #n ")" ::: "memory")
#define PG8_WAIT_L(n) asm volatile("s_waitcnt lgkmcnt(" #n ")" ::: "memory")
#define PG8_BAR __builtin_amdgcn_s_barrier()
#define PG8_SCHED __builtin_amdgcn_sched_barrier(0)
    Unit cur, nxt; int ui = 0;
    if (!S.next(0, cur)) return;
    f32x4 acc[2][2][4][2];
#pragma unroll
    for (int a = 0; a < 2; ++a)
#pragma unroll
        for (int b = 0; b < 2; ++b)
#pragma unroll
            for (int m = 0; m < 4; ++m)
#pragma unroll
                for (int n = 0; n < 2; ++n) acc[a][b][m][n] = (f32x4){0.f, 0.f, 0.f, 0.f};
    typename FragT<F8>::A At; typename FragT<F8>::B B0, B1;
    const char* cA = (const char*)g.A + (size_t)cur.pm * tstep + (size_t)cur.kofs * 2; const char* cB = (const char*)g.Bt + (size_t)cur.pn * tstep + (size_t)cur.kofs * 2;
    S.a_ready(cur);
    if constexpr (SP2) {
        PG8_STAGE(PG8_SB(0, 0), cB, voffB); PG8_STAGE(PG8_SB(0, 1), cB + hstep, voffB); PG8_STAGE(PG8_SA(0, 0), cA, voffA); PG8_STAGE(PG8_SA(0, 1), cA + hstep, voffA);
        if (wr == 1) PG8_BAR;
        PG8_WAIT_V(2); PG8_BAR;
        PG8_STAGE(PG8_SB(1, 0), cB + kstep, voffB); PG8_STAGE(PG8_SA(1, 0), cA + kstep, voffA); PG8_STAGE(PG8_SB(1, 1), cB + hstep + kstep, voffB);
        PG8_WAIT_V(6); PG8_BAR;
    } else {
        PG8_STAGE(PG8_SB(0, 0), cB, voffB); PG8_STAGE(PG8_SA(0, 0), cA, voffA); PG8_STAGE(PG8_SB(0, 1), cB + hstep, voffB); PG8_STAGE(PG8_SA(0, 1), cA + hstep, voffA);
        if (wr == 1) PG8_BAR;
        PG8_WAIT_V(4); PG8_BAR;
        PG8_STAGE(PG8_SB(1, 0), cB + kstep, voffB); PG8_STAGE(PG8_SA(1, 0), cA + kstep, voffA); PG8_STAGE(PG8_SB(1, 1), cB + hstep + kstep, voffB);
        PG8_WAIT_V(6); PG8_BAR;
    }
    for (;;) {
        const bool has_next = S.next(ui + 1, nxt);
        const char* nA = has_next ? (const char*)g.A + (size_t)nxt.pm * tstep + (size_t)nxt.kofs * 2 : cA; const char* nB = has_next ? (const char*)g.Bt + (size_t)nxt.pn * tstep + (size_t)nxt.kofs * 2 : cB;
#pragma nounroll
        for (int t = 0; t < nt; t += 2) {
            const bool last = (t == nt - 2);
            const char* a1 = cA + (size_t)(t + 1) * kstep;
            const char* a2 = last ? nA : cA + (size_t)(t + 2) * kstep; const char* b2 = last ? nB : cB + (size_t)(t + 2) * kstep;
            const char* a3 = a2 + kstep; const char* b3 = b2 + kstep;
            if (last && has_next) S.a_ready(nxt);
            if constexpr (SP2) {
            PG8_LDB(B0, 0, 0); PG8_LDB(B1, 0, 1); PG8_SCHED; PG8_LDA(At, 0, 0); PG8_STAGE(PG8_SA(1, 1), a1 + hstep, voffA);
            PG8_WAIT_V(8); PG8_WAIT_L(0); PG8_BAR; PG8_MMA(0, 0, At, B0); PG8_MMA(0, 1, At, B1); PG8_BAR; PG8_SCHED;
            PG8_LDA(At, 0, 1); PG8_STAGE(PG8_SB(0, 0), b2, voffB); PG8_STAGE(PG8_SB(0, 1), b2 + hstep, voffB); PG8_STAGE(PG8_SA(0, 0), a2, voffA);
            PG8_WAIT_V(8); PG8_WAIT_L(0); PG8_BAR; PG8_MMA(1, 0, At, B0); PG8_MMA(1, 1, At, B1); PG8_BAR; PG8_SCHED;
            PG8_LDB(B0, 1, 0); PG8_LDB(B1, 1, 1); PG8_SCHED; PG8_LDA(At, 1, 0); PG8_STAGE(PG8_SA(0, 1), a2 + hstep, voffA);
            PG8_WAIT_V(8); PG8_WAIT_L(0); PG8_BAR; PG8_MMA(0, 0, At, B0); PG8_MMA(0, 1, At, B1); PG8_BAR; PG8_SCHED;
            PG8_LDA(At, 1, 1); PG8_STAGE(PG8_SB(1, 0), b3, voffB); PG8_STAGE(PG8_SB(1, 1), b3 + hstep, voffB); PG8_STAGE(PG8_SA(1, 0), a3, voffA);
            PG8_WAIT_V(8); PG8_WAIT_L(0); PG8_BAR; PG8_MMA(1, 0, At, B0); PG8_MMA(1, 1, At, B1); PG8_BAR; PG8_SCHED;
            } else {
            PG8_LDB(B0, 0, 0); PG8_SCHED; PG8_LDA(At, 0, 0); PG8_STAGE(PG8_SA(1, 1), a1 + hstep, voffA);
            PG8_WAIT_L(8); PG8_BAR; PG8_WAIT_L(0); PG8_MMA(0, 0, At, B0); PG8_BAR; PG8_SCHED;
            PG8_LDB(B1, 0, 1); PG8_STAGE(PG8_SB(0, 0), b2, voffB);
            PG8_BAR; PG8_WAIT_L(0); PG8_MMA(0, 1, At, B1); PG8_BAR;
            PG8_LDA(At, 0, 1); PG8_STAGE(PG8_SA(0, 0), a2, voffA);
            PG8_BAR; PG8_WAIT_L(0); PG8_MMA(1, 0, At, B0); PG8_BAR; PG8_SCHED;
            PG8_STAGE(PG8_SB(0, 1), b2 + hstep, voffB);
            PG8_WAIT_V(6); PG8_BAR; PG8_MMA(1, 1, At, B1); PG8_BAR;
            PG8_LDB(B0, 1, 0); PG8_SCHED; PG8_LDA(At, 1, 0); PG8_STAGE(PG8_SA(0, 1), a2 + hstep, voffA);
            PG8_WAIT_L(8); PG8_BAR; PG8_WAIT_L(0); PG8_MMA(0, 0, At, B0); PG8_BAR; PG8_SCHED;
            PG8_LDB(B1, 1, 1); PG8_STAGE(PG8_SB(1, 0), b3, voffB);
            PG8_BAR; PG8_WAIT_L(0); PG8_MMA(0, 1, At, B1); PG8_BAR;
            PG8_LDA(At, 1, 1); PG8_STAGE(PG8_SA(1, 0), a3, voffA);
            PG8_BAR; PG8_WAIT_L(0); PG8_MMA(1, 0, At, B0); PG8_BAR; PG8_SCHED;
            PG8_STAGE(PG8_SB(1, 1), b3 + hstep, voffB);
            PG8_WAIT_V(6); PG8_BAR; PG8_MMA(1, 1, At, B1); PG8_BAR;
            }
        }
        if constexpr (ALIGN_EPI) { if (wr == 0) PG8_BAR; }
        if constexpr (!Epi::AFTER_DRAIN) { int t2_ = threadIdx.x; asm volatile("" : "+v"(t2_)); E(acc, cur, wr, wc, t2_ & 15, (t2_ & 63) >> 4); S.done(cur); }
        if (!has_next) break;
#pragma unroll
        for (int a = 0; a < 2; ++a)
#pragma unroll
            for (int b = 0; b < 2; ++b)
#pragma unroll
                for (int m = 0; m < 4; ++m)
#pragma unroll
                    for (int n = 0; n < 2; ++n) acc[a][b][m][n] = (f32x4){0.f, 0.f, 0.f, 0.f};
        cur = nxt; cA = nA; cB = nB; ++ui;
        if constexpr (ALIGN_EPI) { if (wr == 1) PG8_BAR; }
    }
    PG8_WAIT_V(0);
    if constexpr (!ALIGN_EPI) { if (wr == 0) PG8_BAR; }
    PG8_BAR;
    if constexpr (Epi::AFTER_DRAIN) { E.fused(acc, cur, wr, wc, fr, fq, lds, wid, lane); S.done(cur); }
#undef PG8_SA
#undef PG8_SB
#undef PG8_STAGE
#undef PG8_LDA
#undef PG8_LDB
#undef PG8_MMA
#undef PG8_CAT
#undef PG8_WAIT_V
#undef PG8_WAIT_L
#undef PG8_BAR
#undef PG8_SCHED
}
}
#include <hip/hip_bf16.h>
#include <cmath>
namespace attn_body {
using bf16=__hip_bfloat16;
using bf16x8=__attribute__((ext_vector_type(8)))short;
using s16x4=__attribute__((ext_vector_type(4)))short;
using f32x16=__attribute__((ext_vector_type(16)))float;
using u32x4=__attribute__((ext_vector_type(4)))unsigned;
constexpr int D=64,KP=512,OP=1024;
constexpr int NW=8,QBLK=32,QB=QBLK*NW,KVBLK=64;
__device__ __forceinline__ int crow(int r,int hi){return (r&3)+8*(r>>2)+4*hi;}
#define SBAR() __builtin_amdgcn_sched_barrier(0)
__device__ __forceinline__ void cmask(f32x16&p0,f32x16&p1,int jb,int lim){
  const float NEG=-INFINITY;
  if(jb>lim){
  #pragma unroll
  for(int r=0;r<16;++r){p0[r]=NEG;p1[r]=NEG;} }
}

constexpr int NSLOT=3, SLOTB=8192;
constexpr int LDS_K=0, LDS_V=NSLOT*SLOTB, LDS_WS=2*NSLOT*SLOTB, LDS_OST=LDS_WS+NW*64*4, LDS_BYTES=LDS_OST+NW*4096;
constexpr float C2=0.125f*1.4426950408889634f;
__device__ __forceinline__ void glds16(const void*gsrc,unsigned lds_dst){unsigned keep;
  asm volatile("s_mov_b32 %0, m0\n\ts_mov_b32 m0, %2\n\ts_nop 0\n\tglobal_load_lds_dwordx4 %1, off\n\ts_mov_b32 m0, %0":"=&s"(keep):"v"(gsrc),"s"(lds_dst):"memory");}
__device__ __forceinline__ float max3f(float a,float b,float c){float r;asm("v_max3_f32 %0, %1, %2, %3":"=v"(r):"v"(a),"v"(b),"v"(c));return r;}
__device__ __forceinline__ float max2f(float a,float b){float r;asm("v_max_f32_e32 %0, %1, %2":"=v"(r):"v"(a),"v"(b));return r;}
__device__ __forceinline__ float fadd_s(float a,float b){float r;asm("v_add_f32_e32 %0, %1, %2":"=v"(r):"v"(a),"v"(b));return r;}
__device__ __forceinline__ float fsub_s(float a,float b){float r;asm("v_sub_f32_e32 %0, %1, %2":"=v"(r):"v"(a),"v"(b));return r;}
typedef float f32x2_t __attribute__((ext_vector_type(2))); typedef __bf16 bf16x2_t __attribute__((ext_vector_type(2)));
__device__ __forceinline__ unsigned cvtpk_s(float lo,float hi){f32x2_t v={lo,hi};bf16x2_t b=__builtin_convertvector(v,bf16x2_t);return __builtin_bit_cast(unsigned,b);}
#define WAIT_BAR(N) asm volatile("s_waitcnt vmcnt(" #N ") lgkmcnt(0)\n\ts_barrier":::"memory")

__device__ __forceinline__ void qkt(f32x16&p0,f32x16&p1,const char*Kslot,const bf16x8*qr,const f32x16&negm,int r32,int hi){
  const char*kb=Kslot+hi*1024+r32*16;
  #pragma unroll
  for(int d0=0;d0<4;++d0){
    const bf16x8 b0=*reinterpret_cast<const bf16x8*>(kb+d0*2048);
    const bf16x8 b1=*reinterpret_cast<const bf16x8*>(kb+d0*2048+512);
    if(d0==0){p0=__builtin_amdgcn_mfma_f32_32x32x16_bf16(b0,qr[0],negm,0,0,0);p1=__builtin_amdgcn_mfma_f32_32x32x16_bf16(b1,qr[0],negm,0,0,0);}
    else{p0=__builtin_amdgcn_mfma_f32_32x32x16_bf16(b0,qr[d0],p0,0,0,0);p1=__builtin_amdgcn_mfma_f32_32x32x16_bf16(b1,qr[d0],p1,0,0,0);}}
}
typedef __attribute__((address_space(3))) const char* lds_cptr;
typedef short v4i16_t __attribute__((ext_vector_type(4)));
__device__ __forceinline__ void kload8(bf16x8*kf,lds_cptr kp){
  kf[0]=*(const __attribute__((address_space(3))) bf16x8*)(kp);      kf[1]=*(const __attribute__((address_space(3))) bf16x8*)(kp+512);
  kf[2]=*(const __attribute__((address_space(3))) bf16x8*)(kp+2048); kf[3]=*(const __attribute__((address_space(3))) bf16x8*)(kp+2560);
  kf[4]=*(const __attribute__((address_space(3))) bf16x8*)(kp+4096); kf[5]=*(const __attribute__((address_space(3))) bf16x8*)(kp+4608);
  kf[6]=*(const __attribute__((address_space(3))) bf16x8*)(kp+6144); kf[7]=*(const __attribute__((address_space(3))) bf16x8*)(kp+6656);
}
__device__ __forceinline__ void kload2(bf16x8*kf,lds_cptr kp,int j){ kf[2*j]=*(const __attribute__((address_space(3))) bf16x8*)(kp+j*2048); kf[2*j+1]=*(const __attribute__((address_space(3))) bf16x8*)(kp+j*2048+512); }
__device__ __forceinline__ s16x4 vtr(lds_cptr p){ return __builtin_bit_cast(s16x4,__builtin_amdgcn_ds_read_tr16_b64_v4i16((__attribute__((address_space(3))) v4i16_t*)p)); }
__device__ __forceinline__ float rowmax(const f32x16&p0,const f32x16&p1){
  float a=max3f(p0[0],p0[1],p1[0]),b=max3f(p0[2],p0[3],p1[1]);a=max3f(a,p1[2],p1[3]);
  #pragma unroll
  for(int r=4;r<16;r+=4){a=max3f(a,p0[r],p0[r+1]);b=max3f(b,p0[r+2],p0[r+3]);a=max3f(a,p1[r],p1[r+1]);b=max3f(b,p1[r+2],p1[r+3]);}
  const float m=max2f(a,b);
  auto rr=__builtin_amdgcn_permlane32_swap(__float_as_uint(m),__float_as_uint(m),false,false);
  return max2f(__uint_as_float(rr[0]),__uint_as_float(rr[1]));
}
__device__ __forceinline__ void pv(f32x16*o,int vb,bf16x8 pa0,bf16x8 pa1,bf16x8 pa2,bf16x8 pa3){
  #pragma unroll
  for(int d0=0;d0<2;++d0){s16x4 lo[4],hi[4];
    #pragma unroll
    for(int ks=0;ks<4;++ks){
      asm volatile("ds_read_b64_tr_b16 %0,%1 offset:%c2":"=&v"(lo[ks]):"v"(vb),"i"(d0*4096+ks*1024):"memory");
      asm volatile("ds_read_b64_tr_b16 %0,%1 offset:%c2":"=&v"(hi[ks]):"v"(vb),"i"(d0*4096+ks*1024+512):"memory");}
    asm volatile("s_waitcnt lgkmcnt(0)":::"memory");SBAR();
    #define PK(k) (bf16x8){lo[k][0],lo[k][1],lo[k][2],lo[k][3],hi[k][0],hi[k][1],hi[k][2],hi[k][3]}
    o[d0]=__builtin_amdgcn_mfma_f32_32x32x16_bf16(pa0,PK(0),o[d0],0,0,0);
    o[d0]=__builtin_amdgcn_mfma_f32_32x32x16_bf16(pa1,PK(1),o[d0],0,0,0);
    o[d0]=__builtin_amdgcn_mfma_f32_32x32x16_bf16(pa2,PK(2),o[d0],0,0,0);
    o[d0]=__builtin_amdgcn_mfma_f32_32x32x16_bf16(pa3,PK(3),o[d0],0,0,0);
    #undef PK
  }
}

#ifndef ATTN_STORE16
#define ATTN_STORE16(p,v) (*(u32x4*)(p)=(v))
#endif
template<int THRL,bool PART> __device__ __forceinline__ int attn_unit(const bf16*Qb,const bf16*__restrict__ Kh,const bf16*__restrict__ Vh,bf16*Ob,const int NT,const int vlim_in,char*shm,const int s0,const bool primed,const bf16*nKh,const bf16*nVh,bf16*fuseM,const float lam){
  int tid=threadIdx.x; asm volatile("":"+v"(tid));
  const int lane=tid&63,r32=lane&31,hi=lane>>5; const int wid=__builtin_amdgcn_readfirstlane(tid>>6);
  const int vlim=(vlim_in<0)?(wid>>1):vlim_in;
  const bool act=PART?(wid<2):true;
  const bf16*Qw=Qb+(long)(wid*QBLK)*KP;
  const unsigned lds0=(unsigned)(uintptr_t)shm;
  float*wsf=(float*)(shm+LDS_WS)+wid*64;
  const bf16*ksrc=Kh+(long)lane*KP+wid*8;
  const bf16*vsrc=Vh+(long)(16*(wid&3)+(lane>>2))*KP+(wid>>2)*32+(lane&3)*8;
  const unsigned kdst=lds0+LDS_K+wid*1024, vdst=lds0+LDS_V+wid*1024;
  #define DMA_K(t,slot) glds16(ksrc+(long)(t)*KVBLK*KP,(unsigned)__builtin_amdgcn_readfirstlane(kdst+(slot)))
  #define DMA_V(t,slot) glds16(vsrc+(long)(t)*KVBLK*KP,(unsigned)__builtin_amdgcn_readfirstlane(vdst+(slot)))
  const int vb0=(int)(lds0+LDS_V)+((lane>>4)&1)*32+(lane&3)*8+(4*hi+((lane&15)>>2))*64;
  const int s1=(s0==(NSLOT-1)*SLOTB)?0:s0+SLOTB, s2=(s1==(NSLOT-1)*SLOTB)?0:s1+SLOTB;
  const char*Kbase=shm+LDS_K+s0; bf16x8 kf[8];
  const lds_cptr shm3=(lds_cptr)shm; const lds_cptr kp0=shm3+LDS_K+hi*1024+r32*16; const lds_cptr vp0=shm3+LDS_V+((lane>>4)&1)*32+(lane&3)*8+(4*hi+((lane&15)>>2))*64;
  if(!primed){DMA_K(0,s0);DMA_V(0,s0);DMA_K(1,s1);}
  bf16x8 qr[4];
  #pragma unroll
  for(int d0=0;d0<4;++d0)qr[d0]=*reinterpret_cast<const bf16x8*>(&Qw[(long)r32*KP+d0*16+hi*8]);
  float zz_=0.f;asm volatile("":"+v"(zz_));
  float mhat=zz_,l_reg=zz_;f32x16 o[2];
  _Pragma("unroll") for(int r=0;r<16;++r){o[0][r]=zz_;o[1][r]=zz_;}
  f32x16 negm;
  _Pragma("unroll") for(int r=0;r<16;++r)negm[r]=zz_;
  asm volatile("":"+v"(negm));
  #define CMASK(P0,P1,t) do{int jb_=(t)-(NT-4); if(jb_>=0)cmask(P0,P1,jb_,vlim);}while(0)
  bool resc=false;
  #define START(P0,P1) do{ const float rm=rowmax(P0,P1); resc=false; \
    { const float dl=rm; mhat=fadd_s(mhat,dl); \
      _Pragma("unroll") for(int r=0;r<16;++r){P0[r]=fsub_s(P0[r],dl);P1[r]=fsub_s(P1[r],dl);} \
      _Pragma("unroll") for(int r=0;r<16;++r)negm[r]=-mhat; asm volatile("":"+v"(negm)); } \
    _Pragma("unroll") for(int r=0;r<16;++r)P0[r]=__builtin_amdgcn_exp2f(P0[r]); }while(0)
  #define RESC() do{ if(resc){ asm volatile("s_waitcnt lgkmcnt(0)":::"memory"); \
      _Pragma("unroll") for(int d_=0;d_<2;++d_) _Pragma("unroll") for(int r=0;r<16;++r)o[d_][r]*=wsf[crow(r,hi)]; } }while(0)
  f32x16 pA0,pA1,pB0,pB1;
  int sl_prev=s0,sl_cur=s0,sl_next=s1;
  #define ROT() do{sl_prev=sl_cur;sl_cur=sl_next;sl_next=(sl_next==(NSLOT-1)*SLOTB)?0:sl_next+SLOTB;}while(0)
  if(!primed){DMA_K(2,s2);}
  WAIT_BAR(3);
  if(act){
  qkt(pA0,pA1,Kbase,qr,negm,r32,hi);asm volatile("s_nop 15\n\ts_nop 7":"+v"(pA0),"+v"(pA1));CMASK(pA0,pA1,0);
  START(pA0,pA1);
  _Pragma("unroll") for(int r=0;r<16;++r)pA1[r]=__builtin_amdgcn_exp2f(pA1[r]);
  }
  WAIT_BAR(0);
  DMA_K(3,s0);DMA_V(1,s1);
  ROT();
  if(act)kload8(kf,kp0+sl_cur);
  WAIT_BAR(2);
  s16x4 vlo[8],vhi[8]; u32x4 pw0,pw1,pw2,pw3;
  #define PKW(P,B) cvtpk_s(P[B],P[B+1])
  #define PAF(k) __builtin_bit_cast(bf16x8,pw##k)
  #define VFR(i) (bf16x8){vlo[i][0],vlo[i][1],vlo[i][2],vlo[i][3],vhi[i][0],vhi[i][1],vhi[i][2],vhi[i][3]}
  #define PIN(x) asm volatile("":"+v"(x))
  #define MX3(a,b,c) __builtin_fmaxf(__builtin_fmaxf((a),(b)),(c))
  #define GAPA(MF,A0,A1,A2,A3,W0,W1,PW) do{ MF; sacc+=A0; sacc+=A1; sacc+=A2; sacc+=A3; PIN(sacc); W0; W1; PIN(PW); SBAR(); }while(0)
  #define EX(v) __builtin_amdgcn_exp2f(v)
  #define GAPB(MF,X,B) do{ MF; X[B]=EX(X[B]); X[B+1]=EX(X[B+1]); X[B+2]=EX(X[B+2]); X[B+3]=EX(X[B+3]); PIN(X); SBAR(); }while(0)
  #define VRD(i) do{ vlo[i]=vtr(vp_+(((i)>>2)*4096+((i)&3)*1024)); vhi[i]=vtr(vp_+(((i)>>2)*4096+((i)&3)*1024+512)); }while(0)
  #define KRD(G,j) do{ if(G){ kload2(kf,kp0+sl_next,j); SBAR(); } }while(0)
  #define STEP(C0,C1,P0,P1,t,GK,GV,GL) do{ if(act){ SBAR(); \
    const lds_cptr vp_=vp0+sl_prev; \
    VRD(0); SBAR(); float sacc=(P0[0]+P0[1]); \
    GAPA(C0=__builtin_amdgcn_mfma_f32_32x32x16_bf16(kf[0],qr[0],negm,0,0,0), P0[2],P0[3],P0[4],P0[5],     pw0[0]=PKW(P0,0), pw0[1]=PKW(P0,2), pw0); \
    VRD(4); SBAR(); GAPA(C1=__builtin_amdgcn_mfma_f32_32x32x16_bf16(kf[1],qr[0],negm,0,0,0), P0[6],P0[7],P0[8],P0[9],     pw0[2]=PKW(P0,4), pw0[3]=PKW(P0,6), pw0); \
    VRD(1); SBAR(); GAPA(C0=__builtin_amdgcn_mfma_f32_32x32x16_bf16(kf[2],qr[1],C0,0,0,0),   P0[10],P0[11],P0[12],P0[13], pw1[0]=PKW(P0,8), pw1[1]=PKW(P0,10), pw1); \
    VRD(5); SBAR(); GAPA(C1=__builtin_amdgcn_mfma_f32_32x32x16_bf16(kf[3],qr[1],C1,0,0,0),   P0[14],P0[15],P1[0],P1[1],   pw1[2]=PKW(P0,12),pw1[3]=PKW(P0,14), pw1); \
    VRD(2); SBAR(); GAPA(C0=__builtin_amdgcn_mfma_f32_32x32x16_bf16(kf[4],qr[2],C0,0,0,0),   P1[2],P1[3],P1[4],P1[5],     pw2[0]=PKW(P1,0), pw2[1]=PKW(P1,2), pw2); \
    VRD(6); SBAR(); GAPA(C1=__builtin_amdgcn_mfma_f32_32x32x16_bf16(kf[5],qr[2],C1,0,0,0),   P1[6],P1[7],P1[8],P1[9],     pw2[2]=PKW(P1,4), pw2[3]=PKW(P1,6), pw2); \
    VRD(3); SBAR(); GAPA(C0=__builtin_amdgcn_mfma_f32_32x32x16_bf16(kf[6],qr[3],C0,0,0,0),   P1[10],P1[11],P1[12],P1[13], pw3[0]=PKW(P1,8), pw3[1]=PKW(P1,10), pw3); \
    VRD(7); SBAR(); GAPA(C1=__builtin_amdgcn_mfma_f32_32x32x16_bf16(kf[7],qr[3],C1,0,0,0),   P1[14],P1[15],0.f,0.f,       pw3[2]=PKW(P1,12),pw3[3]=PKW(P1,14), pw3); \
    l_reg+=sacc; } \
    if(GK){DMA_K((t)+3,sl_cur);} if(GV){DMA_V((t)+1,sl_next);} \
    if(act){ CMASK(C0,C1,t); \
    { float a=MX3(C0[0],C0[1],C1[0]),b=MX3(C0[2],C0[3],C1[1]); a=MX3(a,C1[2],C1[3]); \
      _Pragma("unroll") for(int r=4;r<16;r+=4){a=MX3(a,C0[r],C0[r+1]);b=MX3(b,C0[r+2],C0[r+3]);a=MX3(a,C1[r],C1[r+1]);b=MX3(b,C1[r+2],C1[r+3]);} \
      float rm=__builtin_fmaxf(a,b); { auto rr=__builtin_amdgcn_permlane32_swap(__float_as_uint(rm),__float_as_uint(rm),false,false); rm=__builtin_fmaxf(__uint_as_float(rr[0]),__uint_as_float(rr[1])); } \
      resc=false; \
      if(__builtin_expect(__any(rm>(float)THRL),0)){ const float dl=__builtin_fmaxf(rm,0.f); mhat+=dl; \
        _Pragma("unroll") for(int r=0;r<16;++r){C0[r]-=dl;C1[r]-=dl;} \
        _Pragma("unroll") for(int r=0;r<16;++r)negm[r]=-mhat; asm volatile("":"+v"(negm)); \
        const float f=__builtin_amdgcn_exp2f(-dl); l_reg*=f; if(hi==0)wsf[r32]=f; resc=true; } } \
    SBAR(); \
    GAPB(o[0]=__builtin_amdgcn_mfma_f32_32x32x16_bf16(PAF(0),VFR(0),o[0],0,0,0), C0,0); \
    GAPB(o[1]=__builtin_amdgcn_mfma_f32_32x32x16_bf16(PAF(0),VFR(4),o[1],0,0,0), C0,4); \
    KRD(GL,0); GAPB(o[0]=__builtin_amdgcn_mfma_f32_32x32x16_bf16(PAF(1),VFR(1),o[0],0,0,0), C0,8); \
    KRD(GL,1); GAPB(o[1]=__builtin_amdgcn_mfma_f32_32x32x16_bf16(PAF(1),VFR(5),o[1],0,0,0), C0,12); \
    KRD(GL,2); GAPB(o[0]=__builtin_amdgcn_mfma_f32_32x32x16_bf16(PAF(2),VFR(2),o[0],0,0,0), C1,0); \
    KRD(GL,3); GAPB(o[1]=__builtin_amdgcn_mfma_f32_32x32x16_bf16(PAF(2),VFR(6),o[1],0,0,0), C1,4); \
    GAPB(o[0]=__builtin_amdgcn_mfma_f32_32x32x16_bf16(PAF(3),VFR(3),o[0],0,0,0), C1,8); \
    GAPB(o[1]=__builtin_amdgcn_mfma_f32_32x32x16_bf16(PAF(3),VFR(7),o[1],0,0,0), C1,12); } \
    }while(0)
  int t=1;
  #undef CMASK
  #define CMASK(P0,P1,t) do{}while(0)
  for(;t+5<NT;t+=2){
    STEP(pB0,pB1,pA0,pA1,t,true,true,true);     WAIT_BAR(2); RESC(); ROT();
    STEP(pA0,pA1,pB0,pB1,t+1,true,true,true);   WAIT_BAR(2); RESC(); ROT();
  }
  #undef CMASK
  #define CMASK(P0,P1,t) do{int jb_=(t)-(NT-4); if(jb_>=0)cmask(P0,P1,jb_,vlim);}while(0)
  #define ENDW(tt) do{ if((tt)+3<NT){WAIT_BAR(2);} else if((tt)+2<NT){WAIT_BAR(1);} else {WAIT_BAR(0);} }while(0)
  for(;t+1<NT;t+=2){
    STEP(pB0,pB1,pA0,pA1,t,(t+3<NT),(t+1<NT),(t+1<NT));       ENDW(t);   RESC(); ROT();
    STEP(pA0,pA1,pB0,pB1,t+1,(t+4<NT),(t+2<NT),(t+2<NT));     ENDW(t+1); RESC(); ROT();
  }
  if(nKh){ const bf16*nks=nKh+(long)lane*KP+wid*8; const bf16*nvs=nVh+(long)(16*(wid&3)+(lane>>2))*KP+(wid>>2)*32+(lane&3)*8;
    const int a0=sl_next, a1=(a0==(NSLOT-1)*SLOTB)?0:a0+SLOTB, a2=(a1==(NSLOT-1)*SLOTB)?0:a1+SLOTB;
    glds16(nks,(unsigned)__builtin_amdgcn_readfirstlane(kdst+a0)); glds16(nvs,(unsigned)__builtin_amdgcn_readfirstlane(vdst+a0));
    glds16(nks+(long)KVBLK*KP,(unsigned)__builtin_amdgcn_readfirstlane(kdst+a1)); glds16(nks+2L*KVBLK*KP,(unsigned)__builtin_amdgcn_readfirstlane(kdst+a2)); }
  STEP(pB0,pB1,pA0,pA1,NT-1,false,false,false); RESC();
  if(act){ float sacc=pB0[0]+pB0[1]; _Pragma("unroll") for(int r=2;r<16;++r)sacc+=pB0[r]; _Pragma("unroll") for(int r=0;r<16;++r)sacc+=pB1[r]; l_reg+=sacc;
    pw0=(u32x4){PKW(pB0,0),PKW(pB0,2),PKW(pB0,4),PKW(pB0,6)};pw1=(u32x4){PKW(pB0,8),PKW(pB0,10),PKW(pB0,12),PKW(pB0,14)};pw2=(u32x4){PKW(pB1,0),PKW(pB1,2),PKW(pB1,4),PKW(pB1,6)};pw3=(u32x4){PKW(pB1,8),PKW(pB1,10),PKW(pB1,12),PKW(pB1,14)};
    SBAR(); pv(o,vb0+sl_cur,PAF(0),PAF(1),PAF(2),PAF(3)); }
  #undef PKW
  #undef PAF
  #undef VFR
  #undef PIN
  #undef MX3
  #undef GAPA
  #undef GAPB
  #undef EX
  #undef VRD
  #undef KRD
  #undef STEP
  #undef ENDW
  if(act){
  {auto rr=__builtin_amdgcn_permlane32_swap(__float_as_uint(l_reg),__float_as_uint(l_reg),false,false);l_reg=__uint_as_float(rr[0])+__uint_as_float(rr[1]);}
  if(hi==0)wsf[32+r32]=l_reg;asm volatile("s_waitcnt lgkmcnt(0)":::"memory");
  float rli[16];
  #pragma unroll
  for(int r=0;r<16;++r)rli[r]=__builtin_amdgcn_rcpf(wsf[32+crow(r,hi)]);
  bf16*Ow=Ob+(long)(wid*QBLK)*OP;
  { bf16*stg=(bf16*)(shm+LDS_OST)+wid*2048;
    #pragma unroll
    for(int r=0;r<16;++r){const int orow=crow(r,hi);
      #pragma unroll
      for(int d0=0;d0<2;++d0)stg[orow*64+d0*32+r32]=__float2bfloat16(o[d0][r]*rli[r]);}
    asm volatile("s_waitcnt lgkmcnt(0)":::"memory");
    if(!fuseM){
    #pragma unroll
    for(int i=0;i<4;++i){const int row=i*8+(lane>>3),ch=lane&7; const u32x4 v=*(const u32x4*)(stg+row*64+ch*8); ATTN_STORE16(Ow+(long)row*OP+ch*8,v);}
    } else {
    asm volatile("s_waitcnt vmcnt(0)":::"memory"); __builtin_amdgcn_fence(__ATOMIC_ACQUIRE,"agent");
    bf16*Mw=fuseM+(long)(wid*QBLK)*OP;
    #pragma unroll
    for(int i=0;i<4;++i){const int row=i*8+(lane>>3),ch=lane&7; const u32x4 v=*(const u32x4*)(stg+row*64+ch*8);
      const bf16*gp=Ow+(long)row*OP+ch*8; const u32x4 a=*(const u32x4*)(gp-192), c1=*(const u32x4*)(gp-128), b=*(const u32x4*)(gp-64);
      float d0[8],d1[8],ss=0.f;
      #pragma unroll
      for(int q=0;q<4;++q){ d0[2*q]=__uint_as_float(a[q]<<16)-lam*__uint_as_float(b[q]<<16); d0[2*q+1]=__uint_as_float(a[q]&0xffff0000u)-lam*__uint_as_float(b[q]&0xffff0000u);
        d1[2*q]=__uint_as_float(c1[q]<<16)-lam*__uint_as_float(v[q]<<16); d1[2*q+1]=__uint_as_float(c1[q]&0xffff0000u)-lam*__uint_as_float(v[q]&0xffff0000u);
        ss+=d0[2*q]*d0[2*q]+d0[2*q+1]*d0[2*q+1]+d1[2*q]*d1[2*q]+d1[2*q+1]*d1[2*q+1]; }
      ss+=__shfl_xor(ss,1); ss+=__shfl_xor(ss,2); ss+=__shfl_xor(ss,4);
      const float rn=rsqrtf(ss*(1.0f/128.0f)+1e-6f)*0.8f;
      u32x4 w0,w1;
      #pragma unroll
      for(int q=0;q<4;++q){ w0[q]=cvtpk_s(d0[2*q]*rn,d0[2*q+1]*rn); w1[q]=cvtpk_s(d1[2*q]*rn,d1[2*q+1]*rn); }
      *(u32x4*)(Mw+(long)row*OP+ch*8)=w0; *(u32x4*)(Mw+(long)row*OP+64+ch*8)=w1; }
    } }
  }
  asm volatile("s_waitcnt lgkmcnt(0)\n\ts_barrier":::"memory");
  #undef DMA_K
  #undef DMA_V
  #undef CMASK
  #undef START
  #undef RESC
  #undef ROT
  return sl_next;
}
constexpr int ATTN_LDS_BYTES=LDS_BYTES;
#undef SBAR
#undef WAIT_BAR
}

namespace pg8 {
constexpr int MPc = 32768;
__device__ __forceinline__ float silu_f(float x) { return x * __builtin_amdgcn_rcpf(1.0f + __builtin_amdgcn_exp2f(-1.4426950408889634f * x)); }
struct EpiSwiGLU {
    static constexpr bool PERM = true, AFTER_DRAIN = false;
    unsigned char* O; int ldc; float inv, oscale;
    __device__ __forceinline__ void operator()(const f32x4 (&acc)[2][2][4][2], const Unit& u, int wr, int wc, int fr, int fq) const {
        const int row0 = u.pm * BM + wr * 64 + fr, col0 = u.pn * HALF + wc * 32 + 8 * fq;
#pragma unroll
        for (int ai = 0; ai < 2; ++ai)
#pragma unroll
            for (int m = 0; m < 4; ++m) { unsigned char* rowp = O + (size_t)(row0 + ai * HALF + m * 16) * ldc + col0;
                const f32x4 g0 = acc[ai][0][m][0] * inv, g1 = acc[ai][0][m][1] * inv, u0 = acc[ai][1][m][0] * (inv * oscale), u1 = acc[ai][1][m][1] * (inv * oscale);
                unsigned w0 = pk4_fp8(silu_f(g0[0]) * u0[0], silu_f(g0[1]) * u0[1], silu_f(g0[2]) * u0[2], silu_f(g0[3]) * u0[3]);
                unsigned w1 = pk4_fp8(silu_f(g1[0]) * u1[0], silu_f(g1[1]) * u1[1], silu_f(g1[2]) * u1[2], silu_f(g1[3]) * u1[3]);
                typedef unsigned u32x2_t __attribute__((ext_vector_type(2))); *(u32x2_t*)rowp = (u32x2_t){w0, w1}; }
    }
};
struct EpiResid {
    static constexpr bool PERM = true, AFTER_DRAIN = false;
    const float* baseP; const float* baseS; float* out; const float* gate; float s;
    __device__ __forceinline__ void operator()(const f32x4 (&acc)[2][2][4][2], const Unit& u, int wr, int wc, int fr, int fq) const {
        const int colb = u.pn * BM + wc * 32 + 8 * fq;
#pragma unroll
        for (int ai = 0; ai < 2; ++ai) {
            const int r0 = u.pm * BM + ai * HALF + wr * 64; const int mb = r0 < MPc ? (r0 >> 12) : 8 + ((r0 - MPc) >> 6);
            f32x4 gv[2][2];
#pragma unroll
            for (int bj = 0; bj < 2; ++bj)
#pragma unroll
                for (int n = 0; n < 2; ++n) gv[bj][n] = *(const f32x4*)(gate + (size_t)mb * 9216 + colb + bj * HALF + 4 * n) * s;
#pragma unroll
            for (int m = 0; m < 4; ++m) { const int row = r0 + m * 16 + fr;
                const float* bp = row < MPc ? baseP + (size_t)row * 1024 : baseS + (size_t)(row - MPc) * 1024; float* op = out + (size_t)row * 1024;
#pragma unroll
                for (int bj = 0; bj < 2; ++bj)
#pragma unroll
                    for (int n = 0; n < 2; ++n) { const int col = colb + bj * HALF + 4 * n; const f32x4 o = *(const f32x4*)(bp + col) + gv[bj][n] * acc[ai][bj][m][n]; *(f32x4*)(op + col) = o; }
            }
        }
    }
};
__device__ __forceinline__ void route_in(unsigned char* ws, float* out, float qscale, int row, int c, f32x4 v0, f32x4 v1) {
    const int pn = c >> 8; const bool smp = row >= MPc; const int sb = (row - MPc) >> 6, ts = row & 63;
    if (pn >= 6 && pn < 8) { v0 = v0 * qscale; v1 = v1 * qscale; }
    u32x4 w; w.x = cvt_pk_bf16(v0[0], v0[1]); w.y = cvt_pk_bf16(v0[2], v0[3]); w.z = cvt_pk_bf16(v1[0], v1[1]); w.w = cvt_pk_bf16(v1[2], v1[3]);
    if (pn < 2) { *(u32x4*)((bf16_t*)(ws + WS_Z) + (size_t)row * 512 + c) = w; }
    else if (pn < 6) { const int cc = c - 512; *(u32x4*)((bf16_t*)(ws + WS_XBC) + (size_t)row * 1024 + cc) = w;
        if (!smp) { const int tt = row & 4095; if (tt >= 4093) { float* p = out + O_CONVP + (size_t)((row >> 12) * 3 + tt - 4093) * 1024 + cc; *(f32x4*)p = v0; *(f32x4*)(p + 4) = v1; } }
        else if (ts >= 61) { float* p = out + O_CONVS + (size_t)(sb * 3 + ts - 61) * 1024 + cc; *(f32x4*)p = v0; *(f32x4*)(p + 4) = v1; } }
    else if (pn < 8) { const int cc = c - 1536; const size_t qrow = smp ? (size_t)(MPc + sb * 256 + ts) : (size_t)row; *(u32x4*)((bf16_t*)(ws + WS_Q) + qrow * 512 + cc) = w; }
    else { const bool isk = pn < 10; const int cc = c - (isk ? 2048 : 2560);
        bf16_t* bp = smp ? (bf16_t*)(ws + (isk ? WS_KS : WS_VS)) + (size_t)(sb * 2176 + 2048 + ts) * 512 + cc : (bf16_t*)(ws + (isk ? WS_K : WS_V)) + (size_t)row * 512 + cc;
        *(u32x4*)bp = w;
        float* fp = smp ? out + (isk ? O_NKS : O_NVS) + (size_t)(row - MPc) * 512 + cc : out + (isk ? O_NKP : O_NVP) + (size_t)row * 512 + cc;
        *(f32x4*)fp = v0; *(f32x4*)(fp + 4) = v1; }
}
struct EpiIn {
    static constexpr bool PERM = true, AFTER_DRAIN = false;
    unsigned char* ws; float* out; float qscale;
    __device__ __forceinline__ void operator()(const f32x4 (&acc)[2][2][4][2], const Unit& u, int wr, int wc, int fr, int fq) const {
        const int colt = u.pn * BM + wc * 32 + 8 * fq;
#pragma unroll
        for (int ai = 0; ai < 2; ++ai)
#pragma unroll
            for (int m = 0; m < 4; ++m) { const int row = u.pm * BM + ai * HALF + wr * 64 + m * 16 + fr;
#pragma unroll
                for (int bj = 0; bj < 2; ++bj) route_in(ws, out, qscale, row, colt + bj * HALF, acc[ai][bj][m][0], acc[ai][bj][m][1]); }
    }
};
struct EpiSlab {
    static constexpr bool PERM = true, AFTER_DRAIN = false;
    bf16_t* slab; int N; int kchunk;
    __device__ __forceinline__ void operator()(const f32x4 (&acc)[2][2][4][2], const Unit& u, int wr, int wc, int fr, int fq) const {
        bf16_t* base = slab + (size_t)(u.kofs / kchunk) * 512 * N; const int colb = u.pn * BM + wc * 32 + 8 * fq;
#pragma unroll
        for (int ai = 0; ai < 2; ++ai)
#pragma unroll
            for (int m = 0; m < 4; ++m) { bf16_t* rp = base + (size_t)(u.pm * BM - MPc + ai * HALF + wr * 64 + m * 16 + fr) * N + colb;
#pragma unroll
                for (int bj = 0; bj < 2; ++bj) { const f32x4 a0 = acc[ai][bj][m][0], a1 = acc[ai][bj][m][1];
                    u32x4 w; w.x = cvt_pk_bf16(a0[0], a0[1]); w.y = cvt_pk_bf16(a0[2], a0[3]); w.z = cvt_pk_bf16(a1[0], a1[1]); w.w = cvt_pk_bf16(a1[2], a1[3]);
                    *(u32x4*)(rp + bj * HALF) = w; } }
    }
};
template <bool BASE_BF16> struct EpiResidB {
    static constexpr bool PERM = true, AFTER_DRAIN = false;
    const void* base; bf16_t* out; const float* gate; float s;
    __device__ __forceinline__ void operator()(const f32x4 (&acc)[2][2][4][2], const Unit& u, int wr, int wc, int fr, int fq) const {
        const int colb = u.pn * BM + wc * 32 + 8 * fq;
#pragma unroll
        for (int ai = 0; ai < 2; ++ai) {
            const int r0 = u.pm * BM + ai * HALF + wr * 64; const int mb = r0 >> 12;
            f32x4 gv[2][2];
#pragma unroll
            for (int bj = 0; bj < 2; ++bj)
#pragma unroll
                for (int n = 0; n < 2; ++n) gv[bj][n] = *(const f32x4*)(gate + (size_t)mb * 9216 + colb + bj * HALF + 4 * n) * s;
#pragma unroll
            for (int m = 0; m < 4; ++m) { const size_t ro = (size_t)(r0 + m * 16 + fr) * 1024;
#pragma unroll
                for (int bj = 0; bj < 2; ++bj) { const int col = colb + bj * HALF; f32x4 b0, b1;
                    if (BASE_BF16) { const u32x4 raw = *(const u32x4*)((const bf16_t*)base + ro + col);
                        b0 = (f32x4){__uint_as_float(raw.x << 16), __uint_as_float(raw.x & 0xffff0000u), __uint_as_float(raw.y << 16), __uint_as_float(raw.y & 0xffff0000u)};
                        b1 = (f32x4){__uint_as_float(raw.z << 16), __uint_as_float(raw.z & 0xffff0000u), __uint_as_float(raw.w << 16), __uint_as_float(raw.w & 0xffff0000u)}; }
                    else { b0 = *(const f32x4*)((const float*)base + ro + col); b1 = *(const f32x4*)((const float*)base + ro + col + 4); }
                    const f32x4 o0 = b0 + gv[bj][0] * acc[ai][bj][m][0], o1 = b1 + gv[bj][1] * acc[ai][bj][m][1];
                    u32x4 w; w.x = cvt_pk_bf16(o0[0], o0[1]); w.y = cvt_pk_bf16(o0[2], o0[3]); w.z = cvt_pk_bf16(o1[0], o1[1]); w.w = cvt_pk_bf16(o1[2], o1[3]);
                    *(u32x4*)(out + ro + col) = w; }
            }
        }
    }
};
struct EpiResidAtomic {
    static constexpr bool PERM = true, AFTER_DRAIN = false;
    float* out; const float* gate; float s;
    __device__ __forceinline__ void operator()(const f32x4 (&acc)[2][2][4][2], const Unit& u, int wr, int wc, int fr, int fq) const {
        const int colb = u.pn * BM + wc * 32 + 8 * fq;
#pragma unroll
        for (int ai = 0; ai < 2; ++ai) {
            const int r0 = u.pm * BM + ai * HALF + wr * 64; const int mb = r0 < MPc ? (r0 >> 12) : 8 + ((r0 - MPc) >> 6);
            f32x4 gv[2][2];
#pragma unroll
            for (int bj = 0; bj < 2; ++bj)
#pragma unroll
                for (int n = 0; n < 2; ++n) gv[bj][n] = *(const f32x4*)(gate + (size_t)mb * 9216 + colb + bj * HALF + 4 * n) * s;
#pragma unroll
            for (int m = 0; m < 4; ++m) { float* op = out + (size_t)(r0 + m * 16 + fr) * 1024 + colb;
#pragma unroll
                for (int bj = 0; bj < 2; ++bj)
#pragma unroll
                    for (int n = 0; n < 2; ++n) { const f32x4 o = gv[bj][n] * acc[ai][bj][m][n]; float* p = op + bj * HALF + 4 * n;
                        unsafeAtomicAdd(p, o[0]); unsafeAtomicAdd(p + 1, o[1]); unsafeAtomicAdd(p + 2, o[2]); unsafeAtomicAdd(p + 3, o[3]); }
            }
        }
    }
};
}

namespace cg = cooperative_groups;
#define GAS __attribute__((address_space(1)))
#define LAS __attribute__((address_space(3)))
typedef unsigned short bf16;
typedef unsigned v4u __attribute__((ext_vector_type(4)));
typedef unsigned v2u __attribute__((ext_vector_type(2)));
typedef float f32x4 __attribute__((ext_vector_type(4)));
typedef short bf16x8 __attribute__((ext_vector_type(8)));
__device__ __forceinline__ float bf2f(unsigned x) { return __uint_as_float(x << 16); }
__device__ __forceinline__ float bflo(unsigned x) { return __uint_as_float(x << 16); }
__device__ __forceinline__ float bfhi(unsigned x) { return __uint_as_float(x & 0xffff0000u); }
__device__ __forceinline__ unsigned pk2(float lo, float hi) { return pg8::cvt_pk_bf16(lo, hi); }
__device__ __forceinline__ float silu_f(float x) { return x * __builtin_amdgcn_rcpf(1.0f + __builtin_amdgcn_exp2f(-1.4426950408889634f * x)); }
__device__ __forceinline__ float wave_sum(float v) {
#pragma unroll
    for (int o = 1; o < 64; o <<= 1) v += __shfl_xor(v, o);
    return v;
}
__device__ __forceinline__ float wave_incl_scan(float a, int lane) {
#pragma unroll
    for (int o = 1; o < 64; o <<= 1) { const float t = __shfl_up(a, o); if (lane >= o) a += t; }
    return a;
}
#define LDS_WAIT() asm volatile("s_waitcnt lgkmcnt(0)" ::: "memory")

__device__ __forceinline__ void ph_mod(const float* cp, const float* cs, const float* w_ada, const float* b_ada, float* MOD, float* MISC,
                                       const float* lq1, const float* lk1, const float* lq2, const float* lk2, LAS unsigned char* lds, int G, int tid) {
    asm volatile("" : "+v"(tid));
    LAS float* scT = (LAS float*)lds;
    LAS float* red = (LAS float*)(lds + 65536);
    const int lane = tid & 63, wave = tid >> 6;
    if ((int)blockIdx.x < 144) for (int i = tid; i < 16384; i += 512) { const int b = i >> 10, k = i & 1023; const float c = b < 8 ? cp[b * 1024 + k] : cs[(b - 8) * 1024 + k]; scT[k * 16 + b] = c / (1.0f + __expf(-c)); }
    __syncthreads();
    for (int unit = blockIdx.x; unit < 144; unit += G) {
        const int col = unit * 64 + lane;
        float acc[16];
#pragma unroll
        for (int b = 0; b < 16; ++b) acc[b] = 0.f;
        const int k0 = wave * 128;
#pragma unroll 16
        for (int kk = 0; kk < 128; ++kk) { const int k = k0 + kk; const float wv = w_ada[(size_t)k * 9216 + col];
            const f32x4 s0 = *(const LAS f32x4*)(scT + k * 16), s1 = *(const LAS f32x4*)(scT + k * 16 + 4), s2 = *(const LAS f32x4*)(scT + k * 16 + 8), s3 = *(const LAS f32x4*)(scT + k * 16 + 12);
            acc[0] += s0[0] * wv; acc[1] += s0[1] * wv; acc[2] += s0[2] * wv; acc[3] += s0[3] * wv; acc[4] += s1[0] * wv; acc[5] += s1[1] * wv; acc[6] += s1[2] * wv; acc[7] += s1[3] * wv;
            acc[8] += s2[0] * wv; acc[9] += s2[1] * wv; acc[10] += s2[2] * wv; acc[11] += s2[3] * wv; acc[12] += s3[0] * wv; acc[13] += s3[1] * wv; acc[14] += s3[2] * wv; acc[15] += s3[3] * wv; }
#pragma unroll
        for (int b = 0; b < 16; ++b) red[(wave * 16 + b) * 64 + lane] = acc[b];
        __syncthreads();
        for (int o = tid; o < 1024; o += 512) { const int b = o >> 6, l = o & 63; float s = 0.f;
#pragma unroll
            for (int w = 0; w < 8; ++w) s += red[(w * 16 + b) * 64 + l];
            MOD[(size_t)b * 9216 + unit * 64 + l] = s + b_ada[unit * 64 + l]; }
        __syncthreads();
    }
    if (blockIdx.x == (unsigned)(G - 1) && wave == 0) { float a = lq1[lane] * lk1[lane], b = lq2[lane] * lk2[lane]; a = wave_sum(a); b = wave_sum(b); if (lane == 0) MISC[0] = __expf(a) - __expf(b) + 0.2f; }
}

template <int MODE> __device__ __forceinline__ int rowmap(int n) {
    if (MODE == 1) { const int f = n < DFF ? n : n - DFF, u = n < DFF ? 0 : 128; return (f >> 7) * 256 + u + (f & 127); }
    if (MODE == 2) { return n < 1536 ? n : (n < 1544 ? -1 : n - 8); }
    return n;
}
template <int MODE, bool F8> __device__ __forceinline__ void transpose_item(const float* W, int K, int N, bf16* WT, LAS float* scr, int item, int lane, float sc) {
    const int nblk = (N + 31) / 32, kb = item / nblk, nb = item % nblk, k0 = 64 * kb, n0 = 32 * nb;
    const int nq = 4 * (lane & 7), nn = n0 + nq;
    f32x4 tv[8];
#pragma unroll
    for (int i = 0; i < 8; ++i) { const int kk = 8 * i + (lane >> 3); tv[i] = nn < N ? *(const f32x4*)(W + (size_t)(k0 + kk) * N + nn) : (f32x4){0.f, 0.f, 0.f, 0.f}; }
#pragma unroll
    for (int i = 0; i < 8; ++i) { const int kk = 8 * i + (lane >> 3); LAS float* d = scr + kk * 33 + nq; d[0] = tv[i][0]; d[1] = tv[i][1]; d[2] = tv[i][2]; d[3] = tv[i][3]; }
    LDS_WAIT(); asm volatile("" ::: "memory");
    const int c = lane & 7;
#pragma unroll
    for (int j = 0; j < 4; ++j) { const int n = (lane >> 3) + 8 * j; const LAS float* s = scr + (8 * c) * 33 + n;
        v4u o; o.x = pk2(s[0 * 33], s[1 * 33]); o.y = pk2(s[2 * 33], s[3 * 33]); o.z = pk2(s[4 * 33], s[5 * 33]); o.w = pk2(s[6 * 33], s[7 * 33]);
        const int r = (n0 + n < N) ? rowmap<MODE>(n0 + n) : -1;
        if (F8) { v2u o8; o8.x = pk4_fp8(s[0 * 33] * sc, s[1 * 33] * sc, s[2 * 33] * sc, s[3 * 33] * sc); o8.y = pk4_fp8(s[4 * 33] * sc, s[5 * 33] * sc, s[6 * 33] * sc, s[7 * 33] * sc);
            if (r >= 0) *(v2u*)((unsigned char*)WT + (size_t)r * K + k0 + 8 * c) = o8; }
        else if (r >= 0) *(v4u*)(WT + (size_t)r * K + k0 + 8 * c) = o; }
    LDS_WAIT(); asm volatile("" ::: "memory");
}

__device__ __forceinline__ void load_row4(const void* base, bool is_bf16, size_t row, int lane, f32x4 (&v)[4]) {
    if (is_bf16) { const v2u* p = (const v2u*)((const bf16*)base + row * DM);
#pragma unroll
        for (int j = 0; j < 4; ++j) { const v2u r = p[lane + 64 * j]; v[j] = (f32x4){bflo(r.x), bfhi(r.x), bflo(r.y), bfhi(r.y)}; } }
    else { const f32x4* p = (const f32x4*)((const float*)base + row * DM);
#pragma unroll
        for (int j = 0; j < 4; ++j) v[j] = p[lane + 64 * j]; }
}
template <bool WITH_DT, bool OUT8> __device__ __forceinline__ void norm_mod_rows(const void* xp, bool pb16, const void* xs, bool sb16, const float* w, const float* MOD, int ish, int isc, bf16* H,
                                                                        int vcu, int G, int tid, const LAS float* sW, const float* dt_bias, float* DT,
                                                                        const bf16* fslab, int fS, const float* fgate, float fsc, bf16* fxout) {
    asm volatile("" : "+v"(tid)); const int lane = tid & 63, gw = vcu * NWAVES + __builtin_amdgcn_readfirstlane(tid >> 6), NGW = G * NWAVES;
    f32x4 wv[4];
#pragma unroll
    for (int j = 0; j < 4; ++j) wv[j] = ((const f32x4*)w)[lane + 64 * j];
    f32x4 wdt[WITH_DT ? 8 : 1][4];
    if (WITH_DT) {
#pragma unroll
        for (int c = 0; c < 8; ++c)
#pragma unroll
            for (int j = 0; j < 4; ++j) wdt[c][j] = *(const LAS f32x4*)(sW + c * 1024 + 4 * (lane + 64 * j)); }
    f32x4 vn[4];
    if (gw < MT) { if (gw < MP) load_row4(xp, pb16, (size_t)gw, lane, vn); else load_row4(xs, sb16, (size_t)(gw - MP), lane, vn); }
    for (int row = gw; row < MT; row += NGW) {
        const int mb = row < MP ? (row >> 12) : 8 + ((row - MP) >> 6);
        f32x4 v[4]; float s = 0.f;
#pragma unroll
        for (int j = 0; j < 4; ++j) v[j] = vn[j];
        { const int rn = row + NGW; if (rn < MT) { if (rn < MP) load_row4(xp, pb16, (size_t)rn, lane, vn); else load_row4(xs, sb16, (size_t)(rn - MP), lane, vn); } }
        if (fslab && row >= MP) {
            f32x4 a[4];
#pragma unroll
            for (int j = 0; j < 4; ++j) a[j] = (f32x4){0.f, 0.f, 0.f, 0.f};
            for (int ks = 0; ks < fS; ++ks) { const v2u* sp = (const v2u*)(fslab + ((size_t)ks * MS + (row - MP)) * DM);
#pragma unroll
                for (int j = 0; j < 4; ++j) { const v2u r = sp[lane + 64 * j]; a[j] += (f32x4){bflo(r.x), bfhi(r.x), bflo(r.y), bfhi(r.y)}; } }
#pragma unroll
            for (int j = 0; j < 4; ++j) { v[j] += ((const f32x4*)(fgate + (size_t)mb * 9216))[lane + 64 * j] * fsc * a[j];
                v2u o; o.x = pk2(v[j][0], v[j][1]); o.y = pk2(v[j][2], v[j][3]); *(v2u*)(fxout + (size_t)row * DM + 4 * (lane + 64 * j)) = o; }
        }
#pragma unroll
        for (int j = 0; j < 4; ++j) s += (v[j][0] * v[j][0] + v[j][1] * v[j][1]) + (v[j][2] * v[j][2] + v[j][3] * v[j][3]);
        const float rstd = rsqrtf(wave_sum(s) * (1.0f / DM) + EPSN);
        const f32x4* sh = (const f32x4*)(MOD + (size_t)mb * 9216 + ish * 1024); const f32x4* sc = (const f32x4*)(MOD + (size_t)mb * 9216 + isc * 1024);
#pragma unroll
        for (int j = 0; j < 4; ++j) { const f32x4 a = v[j] * rstd * wv[j]; v[j] = a * (sc[lane + 64 * j] + 1.0f) + sh[lane + 64 * j];
            if (OUT8) { *(unsigned*)((unsigned char*)H + (size_t)row * DM + 4 * (lane + 64 * j)) = pk4_fp8(v[j][0] * SC_H8, v[j][1] * SC_H8, v[j][2] * SC_H8, v[j][3] * SC_H8); }
            else { v2u o; o.x = pk2(v[j][0], v[j][1]); o.y = pk2(v[j][2], v[j][3]); *(v2u*)(H + (size_t)row * DM + 4 * (lane + 64 * j)) = o; } }
        if (WITH_DT) {
            float d[8];
#pragma unroll
            for (int c = 0; c < 8; ++c) { float p = 0.f;
#pragma unroll
                for (int j = 0; j < 4; ++j) { const f32x4 ww = wdt[WITH_DT ? c : 0][j]; p += (v[j][0] * ww[0] + v[j][1] * ww[1]) + (v[j][2] * ww[2] + v[j][3] * ww[3]); }
                d[c] = p; }
            float e4[4], e2[2], e1;
            { const bool up = (lane & 32) != 0;
#pragma unroll
              for (int c = 0; c < 4; ++c) { const float keep = up ? d[4 + c] : d[c], give = up ? d[c] : d[4 + c]; e4[c] = keep + __shfl_xor(give, 32); } }
            { const bool up = (lane & 16) != 0;
#pragma unroll
              for (int c = 0; c < 2; ++c) { const float keep = up ? e4[2 + c] : e4[c], give = up ? e4[c] : e4[2 + c]; e2[c] = keep + __shfl_xor(give, 16); } }
            { const bool up = (lane & 8) != 0; const float keep = up ? e2[1] : e2[0], give = up ? e2[0] : e2[1]; e1 = keep + __shfl_xor(give, 8); }
            e1 += __shfl_xor(e1, 4); e1 += __shfl_xor(e1, 2); e1 += __shfl_xor(e1, 1);
            const int col = ((lane >> 5) & 1) * 4 + ((lane >> 4) & 1) * 2 + ((lane >> 3) & 1);
            if ((lane & 7) == 0) { const float p = e1 + dt_bias[col]; DT[(size_t)row * 8 + col] = fmaxf(p, 0.f) + log1pf(__expf(-fabsf(p))); }
        }
    }
}

__device__ __forceinline__ void ph_conv(const bf16* XBC, const float* state_conv, const float* conv_w, const float* conv_b, bf16* XT, bf16* BN, bf16* CN, bf16* BT, int c_lo, int c_hi, int vcu, int G, int tid) {
    asm volatile("" : "+v"(tid));
    const int ch = 2 * tid;
    float w0[4], w1[4];
#pragma unroll
    for (int w = 0; w < 4; ++w) { w0[w] = conv_w[w * 1024 + ch]; w1[w] = conv_w[w * 1024 + ch + 1]; }
    const float b0 = conv_b[ch], b1 = conv_b[ch + 1];
#define CONV_LD(itx, dst) do { const int r0_ = ((itx) >> 2) * 64 + ((itx) & 3) * 16; _Pragma("unroll") for (int i = 0; i < 19; ++i) { const int rr_ = r0_ - 3 + i; \
        dst[i] = *(const unsigned*)(XBC + (size_t)(rr_ < 0 ? 0 : rr_) * 1024 + ch); } } while (0)
    unsigned rawn[19];
    if (4 * c_lo + vcu < 4 * c_hi) CONV_LD(4 * c_lo + vcu, rawn);
    for (int it = 4 * c_lo + vcu; it < 4 * c_hi; it += G) {
        const int ci = it >> 2, q = it & 3, row0 = ci * 64 + q * 16; const bool smp = ci >= 512;
        unsigned raw[19];
#pragma unroll
        for (int i = 0; i < 19; ++i) raw[i] = rawn[i];
        if (it + G < 4 * c_hi) CONV_LD(it + G, rawn);
        float p0[3], p1[3];
        if (q == 0 && smp) {
#pragma unroll
            for (int i = 0; i < 3; ++i) { p0[i] = state_conv[(size_t)((ci - 512) * 3 + i) * 1024 + ch]; p1[i] = state_conv[(size_t)((ci - 512) * 3 + i) * 1024 + ch + 1]; }
        } else if (q == 0 && (ci & 63) == 0) {
#pragma unroll
            for (int i = 0; i < 3; ++i) { p0[i] = 0.f; p1[i] = 0.f; }
        } else {
#pragma unroll
            for (int i = 0; i < 3; ++i) { p0[i] = bflo(raw[i]); p1[i] = bfhi(raw[i]); }
        }
#pragma unroll
        for (int t8 = 0; t8 < 2; ++t8) {
            float y0[8], y1[8];
#pragma unroll
            for (int i = 0; i < 8; ++i) { const float x0 = bflo(raw[3 + t8 * 8 + i]), x1 = bfhi(raw[3 + t8 * 8 + i]);
                const float a0 = b0 + w0[0] * p0[0] + w0[1] * p0[1] + w0[2] * p0[2] + w0[3] * x0, a1 = b1 + w1[0] * p1[0] + w1[1] * p1[1] + w1[2] * p1[2] + w1[3] * x1;
                y0[i] = silu_f(a0); y1[i] = silu_f(a1); p0[0] = p0[1]; p0[1] = p0[2]; p0[2] = x0; p1[0] = p1[1]; p1[1] = p1[2]; p1[2] = x1; }
            v4u t0, t1; t0.x = pk2(y0[0], y0[1]); t0.y = pk2(y0[2], y0[3]); t0.z = pk2(y0[4], y0[5]); t0.w = pk2(y0[6], y0[7]);
            t1.x = pk2(y1[0], y1[1]); t1.y = pk2(y1[2], y1[3]); t1.z = pk2(y1[4], y1[5]); t1.w = pk2(y1[6], y1[7]);
            const int tl = q * 16 + t8 * 8;
            if (tid < 256) { const int h = ch >> 6, p = ch & 63; bf16* d = XT + ((size_t)(ci * 8 + h) * 64 + p) * 64 + tl; *(v4u*)d = t0; *(v4u*)(d + 64) = t1; }
            else if (tid < 384) { const int cb = ch - 512, g = cb >> 7, n = cb & 127;
#pragma unroll
                for (int i = 0; i < 8; ++i) *(unsigned*)(BN + (size_t)(row0 + t8 * 8 + i) * 256 + cb) = pk2(y0[i], y1[i]);
                bf16* d = BT + ((size_t)(ci * 2 + g) * 128 + n) * 64 + tl; *(v4u*)d = t0; *(v4u*)(d + 64) = t1; }
            else { const int cc = ch - 768;
#pragma unroll
                for (int i = 0; i < 8; ++i) *(unsigned*)(CN + (size_t)(row0 + t8 * 8 + i) * 256 + cc) = pk2(y0[i], y1[i]); }
        }
    }
}

#undef CONV_LD
__device__ __forceinline__ void ph_ssd_scan(const float* DT, const bf16* XT, const bf16* BT, bf16* HST, const float* state_ssm, const float* a_log, float* ssm_p, float* ssm_s, LAS unsigned char* lds, int vcu, int G, int tid) {
    asm volatile("" : "+v"(tid)); const int lane = tid & 63, wave = __builtin_amdgcn_readfirstlane(tid >> 6);
    const int fr = lane & 15, fq = lane >> 4;
    for (int it = vcu; it < 512; it += G) {
        const bool smp = it >= 256; const int id = it & 255, b = id >> 5, h = (id >> 2) & 7, pq = id & 3, g = h >> 2;
        const float A = -__expf(a_log[h]);
        const int p = pq * 16 + fr, n0 = 16 * wave + 4 * fq;
        f32x4 hst = (f32x4){0.f, 0.f, 0.f, 0.f};
        if (smp) hst = *(const f32x4*)(state_ssm + ((size_t)(b * 8 + h) * 64 + p) * 128 + n0);
        const int nch = smp ? 1 : 64, ci0 = smp ? 512 + b : b * 64;
        LAS float* sWg = (LAS float*)lds;
        LAS float* sDec = (LAS float*)(lds + 16384);
        __syncthreads();
        for (int c = wave; c < nch; c += NWAVES) { const float dtv = DT[(size_t)((ci0 + c) * 64 + lane) * 8 + h]; const float a = wave_incl_scan(dtv * A, lane); const float tot = __shfl(a, 63);
            sWg[c * 64 + lane] = dtv * __expf(tot - a); if (lane == 0) sDec[c] = __expf(tot); }
        __syncthreads();
        if (!smp) {
        LAS unsigned char* sX = lds + 32768;
        bf16x8 br[8][2];
#define SCAN_LD(u, cc) do { const int cl_ = ci0 + (cc); _Pragma("unroll") for (int ks = 0; ks < 2; ++ks) \
            br[u][ks] = *(const bf16x8*)(BT + ((size_t)(cl_ * 2 + g) * 128 + 16 * wave + fr) * 64 + 32 * ks + 8 * fq); } while (0)
#pragma unroll
        for (int u = 0; u < 8; ++u) SCAN_LD(u, u);
        for (int half = 0; half < 2; ++half) {
            __syncthreads();
            { bf16x8 xq[4][2];
#pragma unroll
              for (int i = 0; i < 4; ++i) { const int cq = ci0 + 32 * half + wave + 8 * i;
#pragma unroll
                  for (int ks = 0; ks < 2; ++ks) xq[i][ks] = *(const bf16x8*)(XT + ((size_t)(cq * 8 + h) * 64 + p) * 64 + 32 * ks + 8 * fq); }
#pragma unroll
              for (int i = 0; i < 4; ++i) { const int cl = wave + 8 * i, c = 32 * half + cl;
#pragma unroll
                  for (int ks = 0; ks < 2; ++ks) { const v4u xw = __builtin_bit_cast(v4u, xq[i][ks]); v4u o;
                      const f32x4 w0 = *(const LAS f32x4*)(sWg + c * 64 + 32 * ks + 8 * fq), w1 = *(const LAS f32x4*)(sWg + c * 64 + 32 * ks + 8 * fq + 4);
                      o[0] = pk2(bflo(xw[0]) * w0[0], bfhi(xw[0]) * w0[1]); o[1] = pk2(bflo(xw[1]) * w0[2], bfhi(xw[1]) * w0[3]); o[2] = pk2(bflo(xw[2]) * w1[0], bfhi(xw[2]) * w1[1]); o[3] = pk2(bflo(xw[3]) * w1[2], bfhi(xw[3]) * w1[3]);
                      *(LAS v4u*)(sX + (cl * 16 + fr) * 144 + 64 * ks + 16 * fq) = o; } } }
            __syncthreads();
            for (int c0 = 32 * half; c0 < 32 * half + 32; c0 += 8) {
#pragma unroll
                for (int u = 0; u < 8; ++u) { const int c = c0 + u, ci = ci0 + c, cl = c - 32 * half;
                    f32x4 st = (f32x4){0.f, 0.f, 0.f, 0.f};
#pragma unroll
                    for (int ks = 0; ks < 2; ++ks) { const bf16x8 xa = *(const LAS bf16x8*)(sX + (cl * 16 + fr) * 144 + 64 * ks + 16 * fq);
                        st = __builtin_amdgcn_mfma_f32_16x16x32_bf16(br[u][ks], xa, st, 0, 0, 0); }
                    { const int cn = (c + 8 < 64) ? c + 8 : 63; SCAN_LD(u, cn); }
                    v2u hs; hs.x = pk2(hst[0], hst[1]); hs.y = pk2(hst[2], hst[3]);
                    *(v2u*)(HST + ((size_t)(ci * 8 + h) * 64 + p) * 128 + n0) = hs;
                    hst = hst * sDec[c] + st; }
            }
        }
#undef SCAN_LD
        } else {
        bf16x8 xa_n[2], bb_n[2];
#pragma unroll
        for (int ks = 0; ks < 2; ++ks) { xa_n[ks] = *(const bf16x8*)(XT + ((size_t)(ci0 * 8 + h) * 64 + p) * 64 + 32 * ks + 8 * fq); bb_n[ks] = *(const bf16x8*)(BT + ((size_t)(ci0 * 2 + g) * 128 + 16 * wave + fr) * 64 + 32 * ks + 8 * fq); }
        for (int c = 0; c < nch; ++c) {
            const int ci = ci0 + c;
            bf16x8 xa[2], bb[2];
#pragma unroll
            for (int ks = 0; ks < 2; ++ks) { xa[ks] = xa_n[ks]; bb[ks] = bb_n[ks]; }
            if (c + 1 < nch) { const int cn = ci + 1;
#pragma unroll
                for (int ks = 0; ks < 2; ++ks) { xa_n[ks] = *(const bf16x8*)(XT + ((size_t)(cn * 8 + h) * 64 + p) * 64 + 32 * ks + 8 * fq); bb_n[ks] = *(const bf16x8*)(BT + ((size_t)(cn * 2 + g) * 128 + 16 * wave + fr) * 64 + 32 * ks + 8 * fq); } }
            f32x4 st = (f32x4){0.f, 0.f, 0.f, 0.f};
#pragma unroll
            for (int ks = 0; ks < 2; ++ks) { const v4u xw = __builtin_bit_cast(v4u, xa[ks]); v4u o;
                const f32x4 w0 = *(const LAS f32x4*)(sWg + c * 64 + 32 * ks + 8 * fq), w1 = *(const LAS f32x4*)(sWg + c * 64 + 32 * ks + 8 * fq + 4);
                o[0] = pk2(bflo(xw[0]) * w0[0], bfhi(xw[0]) * w0[1]); o[1] = pk2(bflo(xw[1]) * w0[2], bfhi(xw[1]) * w0[3]); o[2] = pk2(bflo(xw[2]) * w1[0], bfhi(xw[2]) * w1[1]); o[3] = pk2(bflo(xw[3]) * w1[2], bfhi(xw[3]) * w1[3]);
                st = __builtin_amdgcn_mfma_f32_16x16x32_bf16(bb[ks], __builtin_bit_cast(bf16x8, o), st, 0, 0, 0); }
            v2u hs; hs.x = pk2(hst[0], hst[1]); hs.y = pk2(hst[2], hst[3]);
            *(v2u*)(HST + ((size_t)(ci * 8 + h) * 64 + p) * 128 + n0) = hs;
            hst = hst * sDec[c] + st;
        }
        }
        float* dst = smp ? ssm_s : ssm_p;
        *(f32x4*)(dst + ((size_t)(b * 8 + h) * 64 + p) * 128 + n0) = hst;
    }
}

template <int NMT> __device__ __forceinline__ void ssd_out_item(const int ci, const int mt0, const float* DT, const bf16* XT, const bf16* BN, const bf16* CN, const bf16* HST, const bf16* Z, const float* ssd_norm,
                                                                bf16* MIXA, LAS unsigned char* lds, const float A, const float Dh, const int lane, const int wave) {
    LAS float* sCB = (LAS float*)lds;
    LAS float* sAcs = (LAS float*)(lds + 34816);
    LAS float* sDt = (LAS float*)(lds + 36864);
    LAS float* sSS = (LAS float*)(lds + 38912);
    const int h = wave, g = h >> 2, fr = lane & 15, fq = lane >> 4;
        const int row0 = ci * 64;
        { const float dtv = DT[(size_t)(row0 + lane) * 8 + h]; const float a = wave_incl_scan(dtv * A, lane); sAcs[h * 64 + lane] = a; sDt[h * 64 + lane] = dtv; }
        if (NMT == 4 || (wave & 3) == 0) { const int mt = 0, mt0c = (NMT == 4) ? (wave & 3) : mt0; bf16x8 cf[4];
#pragma unroll
          for (int ks = 0; ks < 4; ++ks) cf[ks] = *(const bf16x8*)(CN + (size_t)(row0 + 16 * mt0c + fr) * 256 + g * 128 + 32 * ks + 8 * fq);
#pragma unroll
          for (int st = 0; st < 4; ++st) { f32x4 acc = (f32x4){0.f, 0.f, 0.f, 0.f};
#pragma unroll
              for (int ks = 0; ks < 4; ++ks) { const bf16x8 bfv = *(const bf16x8*)(BN + (size_t)(row0 + 16 * st + fr) * 256 + g * 128 + 32 * ks + 8 * fq); acc = __builtin_amdgcn_mfma_f32_16x16x32_bf16(bfv, cf[ks], acc, 0, 0, 0); }
              *(LAS f32x4*)(sCB + (g * 64 + 16 * mt0c + fr) * 68 + 16 * st + 4 * fq) = acc; } }
        __syncthreads();
        f32x4 acc[4][NMT];
#pragma unroll
        for (int nt = 0; nt < 4; ++nt)
#pragma unroll
            for (int mt = 0; mt < NMT; ++mt) acc[nt][mt] = (f32x4){0.f, 0.f, 0.f, 0.f};
#pragma unroll
        for (int ks = 0; ks < 2; ++ks) {
            bf16x8 xf[4];
#pragma unroll
            for (int nt = 0; nt < 4; ++nt) xf[nt] = *(const bf16x8*)(XT + ((size_t)(ci * 8 + h) * 64 + 16 * nt + fr) * 64 + 32 * ks + 8 * fq);
            const int s0 = 32 * ks + 8 * fq;
            const f32x4 as0 = *(const LAS f32x4*)(sAcs + h * 64 + s0), as1 = *(const LAS f32x4*)(sAcs + h * 64 + s0 + 4), d0 = *(const LAS f32x4*)(sDt + h * 64 + s0), d1 = *(const LAS f32x4*)(sDt + h * 64 + s0 + 4);
#pragma unroll
            for (int mt = 0; mt < NMT; ++mt) { const int l = 16 * (mt0 + mt) + fr; const float al = sAcs[h * 64 + l];
                const f32x4 c0 = *(const LAS f32x4*)(sCB + (g * 64 + l) * 68 + s0), c1 = *(const LAS f32x4*)(sCB + (g * 64 + l) * 68 + s0 + 4);
                float mv[8];
#pragma unroll
                for (int j = 0; j < 4; ++j) { mv[j] = (s0 + j <= l) ? c0[j] * __expf(fminf(al - as0[j], 0.f)) * d0[j] : 0.f; mv[4 + j] = (s0 + 4 + j <= l) ? c1[j] * __expf(fminf(al - as1[j], 0.f)) * d1[j] : 0.f; }
#pragma unroll
                for (int j = 0; j < 8; ++j) if (s0 + j == l) mv[j] += Dh;
                v4u mw; mw.x = pk2(mv[0], mv[1]); mw.y = pk2(mv[2], mv[3]); mw.z = pk2(mv[4], mv[5]); mw.w = pk2(mv[6], mv[7]);
                const bf16x8 mf = __builtin_bit_cast(bf16x8, mw);
#pragma unroll
                for (int nt = 0; nt < 4; ++nt) acc[nt][mt] = __builtin_amdgcn_mfma_f32_16x16x32_bf16(xf[nt], mf, acc[nt][mt], 0, 0, 0); }
        }
#pragma unroll
        for (int ks = 0; ks < 4; ++ks) {
            bf16x8 hf[4];
#pragma unroll
            for (int nt = 0; nt < 4; ++nt) hf[nt] = *(const bf16x8*)(HST + ((size_t)(ci * 8 + h) * 64 + 16 * nt + fr) * 128 + 32 * ks + 8 * fq);
#pragma unroll
            for (int mt = 0; mt < NMT; ++mt) { const int l = 16 * (mt0 + mt) + fr; const float e = __expf(sAcs[h * 64 + l]);
                const v4u cw = *(const v4u*)(CN + (size_t)(row0 + l) * 256 + g * 128 + 32 * ks + 8 * fq); v4u o;
#pragma unroll
                for (int j = 0; j < 4; ++j) o[j] = pk2(bflo(cw[j]) * e, bfhi(cw[j]) * e);
                const bf16x8 cs = __builtin_bit_cast(bf16x8, o);
#pragma unroll
                for (int nt = 0; nt < 4; ++nt) acc[nt][mt] = __builtin_amdgcn_mfma_f32_16x16x32_bf16(hf[nt], cs, acc[nt][mt], 0, 0, 0); }
        }
#pragma unroll
        for (int mt = 0; mt < NMT; ++mt) { float ss = 0.f;
#pragma unroll
            for (int nt = 0; nt < 4; ++nt) { const v2u zr = *(const v2u*)(Z + (size_t)(row0 + 16 * (mt0 + mt) + fr) * 512 + h * 64 + 16 * nt + 4 * fq);
                f32x4 y = acc[nt][mt]; y[0] *= silu_f(bflo(zr.x)); y[1] *= silu_f(bfhi(zr.x)); y[2] *= silu_f(bflo(zr.y)); y[3] *= silu_f(bfhi(zr.y)); acc[nt][mt] = y;
                ss += (y[0] * y[0] + y[1] * y[1]) + (y[2] * y[2] + y[3] * y[3]); }
            ss += __shfl_xor(ss, 16); ss += __shfl_xor(ss, 32);
            if (fq == 0) sSS[h * 64 + 16 * (mt0 + mt) + fr] = ss; }
        __syncthreads();
#pragma unroll
        for (int mt = 0; mt < NMT; ++mt) { const int l = 16 * (mt0 + mt) + fr; float tot = 0.f;
#pragma unroll
            for (int w = 0; w < 8; ++w) tot += sSS[w * 64 + l];
            const float rstd = rsqrtf(tot * (1.0f / 512.0f) + EPSN);
#pragma unroll
            for (int nt = 0; nt < 4; ++nt) { const f32x4 nw = *(const f32x4*)(ssd_norm + h * 64 + 16 * nt + 4 * fq); const f32x4 o = acc[nt][mt] * rstd * nw;
                v2u ow; ow.x = pk2(o[0], o[1]); ow.y = pk2(o[2], o[3]); *(v2u*)(MIXA + (size_t)(row0 + l) * 1024 + h * 64 + 16 * nt + 4 * fq) = ow; } }
        __syncthreads();
}
__device__ __forceinline__ void ph_ssd_out(const float* DT, const bf16* XT, const bf16* BN, const bf16* CN, const bf16* HST, const bf16* Z, const float* a_log, const float* d_skip, const float* ssd_norm,
                                           bf16* MIXA, LAS unsigned char* lds, int vcu, int G, int tid) {
    asm volatile("" : "+v"(tid)); const int lane = tid & 63, wave = __builtin_amdgcn_readfirstlane(tid >> 6);
    const float A = -__expf(a_log[wave]), Dh = d_skip[wave];
    for (int ci = vcu; ci < 512; ci += G) ssd_out_item<4>(ci, 0, DT, XT, BN, CN, HST, Z, ssd_norm, MIXA, lds, A, Dh, lane, wave);
    for (int it = vcu; it < 32; it += G) ssd_out_item<1>(512 + (it >> 2), it & 3, DT, XT, BN, CN, HST, Z, ssd_norm, MIXA, lds, A, Dh, lane, wave);
}

__device__ __forceinline__ void ph_combine(const bf16* ATTO, const bf16* ATTOS, const float* MISC, bf16* MIXA, int vcu, int G, int tid, int row_lo) {
    asm volatile("" : "+v"(tid)); const int lane = tid & 63, gw = vcu * NWAVES + __builtin_amdgcn_readfirstlane(tid >> 6), NGW = G * NWAVES;
    const float lam = MISC[0];
    const int hh = lane >> 4, e0 = (lane & 15) * 8;
    v4u an = (v4u){0u, 0u, 0u, 0u}, bn = an;
    const int gs = row_lo + gw;
    if (gs < MT) { const bf16* orow = gs < MP ? ATTO + (size_t)gs * 1024 : ATTOS + (size_t)(((gs - MP) >> 6) * 256 + (gs & 63)) * 1024; an = *(const v4u*)(orow + (hh * 2) * 128 + e0); bn = *(const v4u*)(orow + (hh * 2 + 1) * 128 + e0); }
    for (int row = gs; row < MT; row += NGW) {
        const v4u a = an, b = bn;
        { const int rn = row + NGW; if (rn < MT) { const bf16* orow = rn < MP ? ATTO + (size_t)rn * 1024 : ATTOS + (size_t)(((rn - MP) >> 6) * 256 + (rn & 63)) * 1024; an = *(const v4u*)(orow + (hh * 2) * 128 + e0); bn = *(const v4u*)(orow + (hh * 2 + 1) * 128 + e0); } }
        float o[8]; float ss = 0.f;
#pragma unroll
        for (int j = 0; j < 4; ++j) { o[2 * j] = bflo(a[j]) - lam * bflo(b[j]); o[2 * j + 1] = bfhi(a[j]) - lam * bfhi(b[j]); ss += o[2 * j] * o[2 * j] + o[2 * j + 1] * o[2 * j + 1]; }
        ss += __shfl_xor(ss, 1); ss += __shfl_xor(ss, 2); ss += __shfl_xor(ss, 4); ss += __shfl_xor(ss, 8);
        const float r = rsqrtf(ss * (1.0f / 128.0f) + EPSN) * 0.8f;
        v4u w; w.x = pk2(o[0] * r, o[1] * r); w.y = pk2(o[2] * r, o[3] * r); w.z = pk2(o[4] * r, o[5] * r); w.w = pk2(o[6] * r, o[7] * r);
        *(v4u*)(MIXA + (size_t)row * 1024 + 512 + hh * 128 + e0) = w;
    }
}

__device__ __forceinline__ void ph_final(const bf16* X3, float* Y, const float* w, int vcu, int G, int tid, const bf16* fslab, int fS, const float* fgate, float fsc) {
    asm volatile("" : "+v"(tid)); const int lane = tid & 63, gw = vcu * NWAVES + __builtin_amdgcn_readfirstlane(tid >> 6), NGW = G * NWAVES;
    f32x4 wv[4];
#pragma unroll
    for (int j = 0; j < 4; ++j) wv[j] = ((const f32x4*)w)[lane + 64 * j];
    f32x4 vn[4];
    if (gw < MT) load_row4(X3, true, (size_t)gw, lane, vn);
    for (int row = gw; row < MT; row += NGW) {
        f32x4 v[4]; float s = 0.f;
#pragma unroll
        for (int j = 0; j < 4; ++j) v[j] = vn[j];
        if (row + NGW < MT) load_row4(X3, true, (size_t)(row + NGW), lane, vn);
        if (row >= MP) { const int mb = 8 + ((row - MP) >> 6);
            f32x4 a[4];
#pragma unroll
            for (int j = 0; j < 4; ++j) a[j] = (f32x4){0.f, 0.f, 0.f, 0.f};
            for (int ks = 0; ks < fS; ++ks) { const v2u* sp = (const v2u*)(fslab + ((size_t)ks * MS + (row - MP)) * DM);
#pragma unroll
                for (int j = 0; j < 4; ++j) { const v2u r = sp[lane + 64 * j]; a[j] += (f32x4){bflo(r.x), bfhi(r.x), bflo(r.y), bfhi(r.y)}; } }
#pragma unroll
            for (int j = 0; j < 4; ++j) v[j] += ((const f32x4*)(fgate + (size_t)mb * 9216))[lane + 64 * j] * fsc * a[j];
        }
#pragma unroll
        for (int j = 0; j < 4; ++j) s += (v[j][0] * v[j][0] + v[j][1] * v[j][1]) + (v[j][2] * v[j][2] + v[j][3] * v[j][3]);
        const float rstd = rsqrtf(wave_sum(s) * (1.0f / DM) + EPSN);
        f32x4* yr = (f32x4*)(Y + (size_t)row * DM);
#pragma unroll
        for (int j = 0; j < 4; ++j) yr[lane + 64 * j] = v[j] * rstd * wv[j];
    }
}

__device__ __forceinline__ int opq(int v) { asm volatile("" : "+s"(v)); return v; }
__device__ __forceinline__ void finish_gu(const bf16* slab, unsigned char* ACT8, int vcu, int G, int tid) {
    asm volatile("" : "+v"(tid)); const int gt = vcu * 512 + tid, NT_ = G * 512;
    for (int i = gt; i < 512 * 704; i += NT_) { const int r = i / 704, f = (i - r * 704) * 4, c = (f >> 7) * 256 + (f & 127);
        f32x4 g = (f32x4){0.f, 0.f, 0.f, 0.f}, u = g;
#pragma unroll
        for (int ks = 0; ks < 2; ++ks) { const bf16* p = slab + ((size_t)ks * 512 + r) * NGU + c; const v2u gr = *(const v2u*)p, ur = *(const v2u*)(p + 128);
            g += (f32x4){bflo(gr.x), bfhi(gr.x), bflo(gr.y), bfhi(gr.y)}; u += (f32x4){bflo(ur.x), bfhi(ur.x), bflo(ur.y), bfhi(ur.y)}; }
        g = g * INV_GU; u = u * (INV_GU * SC_ACT8);
        *(unsigned*)(ACT8 + (size_t)(MP + r) * DFF + f) = pk4_fp8(silu_f(g[0]) * u[0], silu_f(g[1]) * u[1], silu_f(g[2]) * u[2], silu_f(g[3]) * u[3]); }
}
__device__ __forceinline__ void finish_in(const bf16* slab, unsigned char* ws, float* out, float qscale, int vcu, int G, int tid) {
    asm volatile("" : "+v"(tid)); const int gt = vcu * 512 + tid, NT_ = G * 512;
    for (int i = gt; i < 512 * 384; i += NT_) { const int r = i / 384, c = (i - r * 384) * 8;
        f32x4 v0 = (f32x4){0.f, 0.f, 0.f, 0.f}, v1 = v0;
#pragma unroll
        for (int ks = 0; ks < 2; ++ks) { const v4u r4 = *(const v4u*)(slab + ((size_t)ks * 512 + r) * NIN + c); v0 += (f32x4){bflo(r4.x), bfhi(r4.x), bflo(r4.y), bfhi(r4.y)}; v1 += (f32x4){bflo(r4.z), bfhi(r4.z), bflo(r4.w), bfhi(r4.w)}; }
        pg8::route_in(ws, out, qscale, MP + r, c, v0, v1); }
}
__device__ __forceinline__ void flag_arrive(unsigned* cnt, int tid) {
    asm volatile("s_waitcnt vmcnt(0)" ::: "memory"); __syncthreads();
    if (tid == 0) { __builtin_amdgcn_fence(__ATOMIC_RELEASE, "agent"); asm volatile("s_waitcnt vmcnt(0)" ::: "memory"); (void)__hip_atomic_fetch_add(cnt, 1u, __ATOMIC_RELAXED, __HIP_MEMORY_SCOPE_AGENT); }
}
__device__ __forceinline__ void flag_wait(unsigned* cnt, unsigned want, int tid) {
    if (tid == 0) { unsigned sp = 0; while (__hip_atomic_load(cnt, __ATOMIC_RELAXED, __HIP_MEMORY_SCOPE_AGENT) < want) { __builtin_amdgcn_s_sleep(2); if (++sp > (1u << 22)) break; }
        __builtin_amdgcn_fence(__ATOMIC_ACQUIRE, "agent"); asm volatile("s_waitcnt vmcnt(0)" ::: "memory"); }
    __syncthreads();
}

#define XB_TMO      128
#define XB_XCNT(j)  (256  + 64 * (j))
#define XB_XSUB(j)  (1280 + 64 * (j))
#define XB_XGEN(j)  (2304 + 64 * (j))
#define XB_TOP      3328
#define XB_TOPGEN   3392
#define XCD_BAR_WORDS 3456
#define XB_SPIN_CAP (1u << 18)

__device__ __forceinline__ unsigned xb_ld(unsigned* p)              { return __hip_atomic_load(p, __ATOMIC_RELAXED, __HIP_MEMORY_SCOPE_AGENT); }
__device__ __forceinline__ unsigned xb_add(unsigned* p, unsigned v) { return __hip_atomic_fetch_add(p, v, __ATOMIC_RELAXED, __HIP_MEMORY_SCOPE_AGENT); }
__device__ __forceinline__ unsigned xb_xcc_id() { return (unsigned)__builtin_amdgcn_s_getreg((3 << 11) | 20) & 0xFu; }
#define XB_SPIN(cond, bar) do { unsigned _sp = 0; while (cond) { __builtin_amdgcn_s_sleep(1); \
    if ((++_sp & 255u) == 0u) { if (xb_ld(&(bar)[XB_TMO])) break; if (_sp > XB_SPIN_CAP) { atomicAdd(&(bar)[XB_TMO], 1u); break; } } } } while (0)

struct XcdBarrier {
    unsigned* bar; unsigned x;
    volatile LAS unsigned* st;
};

__device__ __forceinline__ XcdBarrier xcd_barrier_post(unsigned* bar, volatile LAS unsigned* st) {
    XcdBarrier b; b.bar = bar; b.x = xb_xcc_id(); b.st = st;
    if (threadIdx.x == 0) (void)xb_add(&bar[XB_XCNT(b.x)], 1u);
    return b;
}
__device__ __forceinline__ void xcd_barrier_complete(unsigned* bar, unsigned x, unsigned& nloc, unsigned& nx) {
    const unsigned G = gridDim.x * gridDim.y * gridDim.z;
    unsigned sum, cnt, mine, sp = 0u;
    for (;;) {
        sum = 0u; cnt = 0u; mine = 0u;
#pragma unroll
        for (unsigned j = 0; j < 16; ++j) { const unsigned c = xb_ld(&bar[XB_XCNT(j)]); sum += c; cnt += (c > 0u) ? 1u : 0u; mine = (j == x) ? c : mine; }
        if (sum == G) break;
        __builtin_amdgcn_s_sleep(1);
        if ((++sp & 255u) == 0u) { if (xb_ld(&bar[XB_TMO])) break; if (sp > XB_SPIN_CAP) { atomicAdd(&bar[XB_TMO], 1u); break; } }
    }
    nloc = mine > 0u ? mine : 1u; nx = cnt > 0u ? cnt : 1u;
}

__device__ __forceinline__ void xcd_barrier(const XcdBarrier& b) {
    asm volatile("s_waitcnt vmcnt(0)" ::: "memory");
    __syncthreads();
    if (threadIdx.x == 0) {
        unsigned* bar = b.bar;
        __builtin_amdgcn_s_waitcnt(0);
        unsigned nloc = b.st[0], nx = b.st[1];
        if (nloc == 0u) { xcd_barrier_complete(bar, b.x, nloc, nx); b.st[0] = nloc; b.st[1] = nx; }
        const unsigned old = xb_add(&bar[XB_XSUB(b.x)], 1u);
        const unsigned gen = old / nloc;
        if (old + 1u == (gen + 1u) * nloc) {
            __builtin_amdgcn_fence(__ATOMIC_RELEASE, "agent");
            asm volatile("s_waitcnt vmcnt(0)" ::: "memory");
            const unsigned og = xb_add(&bar[XB_TOP], 1u);
            const unsigned tg = og / nx;
            if (og + 1u == (tg + 1u) * nx) xb_add(&bar[XB_TOPGEN], 1u);
            else XB_SPIN(xb_ld(&bar[XB_TOPGEN]) == tg, bar);
            __builtin_amdgcn_fence(__ATOMIC_ACQUIRE, "agent");
            xb_add(&bar[XB_XGEN(b.x)], 1u);
            asm volatile("s_waitcnt vmcnt(0)" ::: "memory");
        } else {
            XB_SPIN(xb_ld(&bar[XB_XGEN(b.x)]) == gen, bar);
            __builtin_amdgcn_fence(__ATOMIC_ACQUIRE, "agent");
            asm volatile("s_waitcnt vmcnt(0)" ::: "memory");
        }
    }
    __syncthreads();
}

template <int I> __device__ __forceinline__ const float* karg_in() {
    unsigned long long v;
    asm volatile("s_load_dwordx2 %0, %1, %2\n\ts_waitcnt lgkmcnt(0)" : "=s"(v) : "s"(__builtin_amdgcn_kernarg_segment_ptr()), "n"(I * 8) : "memory");
    return (const float*)v;
}
struct Args { const float* in[30]; float* out; unsigned char* ws; int ph_lo, ph_hi, coop, pad; };
__global__ void __launch_bounds__(NWAVES * 64, 2) mk_fwd(Args args) {
    extern __shared__ __attribute__((aligned(16))) unsigned char lds[];
    LAS unsigned char* L = (LAS unsigned char*)lds;
    const int tid = threadIdx.x;
    const int G = gridDim.x, bx = blockIdx.x; const int vcu = (G % 8 == 0) ? (bx % 8) * (G / 8) + bx / 8 : bx;
    unsigned char* ws = args.ws; float* out = args.out;
#define MOD ((float*)(ws + WS_MOD))
#define MISC ((float*)(ws + WS_MISC))
#define DT ((float*)(ws + WS_DT))
#define Wgu1 ((bf16*)(ws + WS_WGU1))
#define Wd1 ((bf16*)(ws + WS_WD1))
#define Win ((bf16*)(ws + WS_WIN))
#define Wout ((bf16*)(ws + WS_WOUT))
#define Wgu2 ((bf16*)(ws + WS_WGU2))
#define Wd2 ((bf16*)(ws + WS_WD2))
#define H ((bf16*)(ws + WS_H))
#define ACT ((bf16*)(ws + WS_ACT))
#define XBC ((bf16*)(ws + WS_XBC))
#define Zb ((bf16*)(ws + WS_Z))
#define Qb ((bf16*)(ws + WS_Q))
#define Kb ((bf16*)(ws + WS_K))
#define Vb ((bf16*)(ws + WS_V))
#define KS ((bf16*)(ws + WS_KS))
#define VS ((bf16*)(ws + WS_VS))
#define XT ((bf16*)(ws + WS_XT))
#define BN ((bf16*)(ws + WS_BN))
#define CN ((bf16*)(ws + WS_CN))
#define BT ((bf16*)(ws + WS_BT))
#define HST ((bf16*)(ws + WS_HST))
#define ATTO ((bf16*)(ws + WS_ATTO))
#define ATTOS ((bf16*)(ws + WS_ATTOS))
#define XB ((bf16*)out)
#define X3 ((bf16*)(ws + WS_H))
    const int lo = args.ph_lo, hi = args.ph_hi;
    volatile LAS unsigned* LCTL = (volatile LAS unsigned*)(L + 131072);
    if (tid < 64) LCTL[tid] = 0u;
    __syncthreads();
    XcdBarrier bar; bar.bar = (unsigned*)(ws + WS_CTL) + 4096; bar.x = 0; bar.st = nullptr;
    if (args.coop) bar = xcd_barrier_post((unsigned*)(ws + WS_CTL) + 4096, LCTL + 8);
#define IN(k) (lo <= (k) && (k) < hi)
#define CNT(i) ((unsigned*)(ws + WS_CTL) + 8192 + 64 * (i))
#ifndef REP_MASK
#define REP_MASK 0
#endif
#define REPS(k) (((REP_MASK >> (k)) & 1) ? 2 : 1)
#define SEAM(k) do { if (IN(k) && IN((k) + 1)) { xcd_barrier(bar); } } while (0)

    if (IN(0)) for (int rep_ = 0; rep_ < REPS(0); ++rep_) { ph_mod(karg_in<6>(), karg_in<7>(), karg_in<8>(), karg_in<9>(), MOD, MISC, karg_in<21>(), karg_in<22>(), karg_in<23>(), karg_in<24>(), L, G, tid); flag_arrive(CNT(3), tid); }
    if (args.coop == 2) cg::this_grid().sync();
    if (IN(1)) for (int rep_ = 0; rep_ < REPS(1); ++rep_) {
        int t1 = tid; asm volatile("" : "+v"(t1)); const int lane = t1 & 63, wave = __builtin_amdgcn_readfirstlane(t1 >> 6), gw = vcu * NWAVES + wave, NGW = G * NWAVES;
        LAS float* scr = (LAS float*)(L + wave * 16384);
        constexpr int I_GU = (DM / 64) * (NGU / 32), I_D = (DFF / 64) * (DM / 32), I_IN = (DM / 64) * ((INC + 31) / 32), I_O = (DM / 64) * (DM / 32);
        constexpr int NITEMS = 2 * I_GU + 2 * I_D + I_IN + I_O;
        for (int it = gw; it < NITEMS; it += NGW) { int r = it;
            if (r < I_GU) { transpose_item<1, true>(karg_in<11>(), DM, NGU, Wgu1, scr, r, lane, SC_WGU8); continue; } r -= I_GU;
            if (r < I_GU) { transpose_item<1, true>(karg_in<27>(), DM, NGU, Wgu2, scr, r, lane, SC_WGU8); continue; } r -= I_GU;
            if (r < I_D) { transpose_item<0, true>(karg_in<12>(), DFF, DM, Wd1, scr, r, lane, SC_WD8); continue; } r -= I_D;
            if (r < I_D) { transpose_item<0, true>(karg_in<28>(), DFF, DM, Wd2, scr, r, lane, SC_WD8); continue; } r -= I_D;
            if (r < I_IN) { transpose_item<2, false>(karg_in<14>(), DM, INC, Win, scr, r, lane, 1.0f); continue; } r -= I_IN;
            transpose_item<0, false>(karg_in<25>(), DM, DM, Wout, scr, r, lane, 1.0f);
        }
        { const float* ck = karg_in<2>(); const float* cv = karg_in<3>(); const int gt = vcu * 512 + tid, NT_ = G * 512;
          for (int i0 = gt; i0 < 8 * 2048 * 64; i0 += 2 * NT_) {
              f32x4 a0[2], a1[2], b0[2], b1[2]; size_t dofs[2];
#pragma unroll
              for (int u = 0; u < 2; ++u) { const int i = i0 + u * NT_; const int c8 = i & 63, t = (i >> 6) & 2047, sb = i >> 17; const size_t so = ((size_t)(sb * 2048 + t) * 512 + c8 * 8); dofs[u] = ((size_t)(sb * 2176 + t) * 512 + c8 * 8);
                  const bool ok = i < 8 * 2048 * 64; const size_t s2 = ok ? so : 0; if (!ok) dofs[u] = (size_t)-1;
                  a0[u] = *(const f32x4*)(ck + s2); a1[u] = *(const f32x4*)(ck + s2 + 4); b0[u] = *(const f32x4*)(cv + s2); b1[u] = *(const f32x4*)(cv + s2 + 4); }
#pragma unroll
              for (int u = 0; u < 2; ++u) if (dofs[u] != (size_t)-1) { v4u w; w.x = pk2(a0[u][0], a0[u][1]); w.y = pk2(a0[u][2], a0[u][3]); w.z = pk2(a1[u][0], a1[u][1]); w.w = pk2(a1[u][2], a1[u][3]); *(v4u*)(KS + dofs[u]) = w;
                  w.x = pk2(b0[u][0], b0[u][1]); w.y = pk2(b0[u][2], b0[u][3]); w.z = pk2(b1[u][0], b1[u][1]); w.w = pk2(b1[u][2], b1[u][3]); *(v4u*)(VS + dofs[u]) = w; } }
          for (int i = gt; i < 8 * 64 * 64; i += NT_) { const int c8 = i & 63, t = (i >> 6) & 63, sb = i >> 12; const size_t dofs = ((size_t)(sb * 2176 + 2112 + t) * 512 + c8 * 8);
              *(v4u*)(KS + dofs) = (v4u){0u, 0u, 0u, 0u}; *(v4u*)(VS + dofs) = (v4u){0u, 0u, 0u, 0u}; } }
        flag_wait(CNT(3), (unsigned)G, tid);
        norm_mod_rows<false, true>(karg_in<0>(), false, karg_in<1>(), false, karg_in<10>(), MOD, 0, 1, H, vcu, G, tid, nullptr, nullptr, nullptr, nullptr, 0, nullptr, 0.f, nullptr);
    }
    SEAM(1);
    if (IN(2)) for (int rep_ = 0; rep_ < REPS(2); ++rep_) { { pg8::Gemm g{H, Wgu1, MP, NGU, DM / 2, DM / 2}; pg8::StaticOrder S; S.init(MP, NGU, G, bx); pg8::EpiSwiGLU E{(unsigned char*)ACT, DFF, INV_GU, SC_ACT8};
        pg8::gemm_phase<pg8::EpiSwiGLU, pg8::StaticOrder, true, true, true>(L, g, S, E); }
        { pg8::Gemm g{H, Wgu1, MS, NGU, opq(256), DM / 2}; pg8::SplitOrder S; S.init(2, NGU, 2, 256, MP / 256, G, vcu); pg8::EpiSlab E{(bf16*)(ws + WS_XT), NGU, 256};
        pg8::gemm_phase<pg8::EpiSlab, pg8::SplitOrder, true, true, true>(L, g, S, E); } }
    SEAM(2);
    if (IN(3)) for (int rep_ = 0; rep_ < REPS(3); ++rep_) { finish_gu((const bf16*)(ws + WS_XT), (unsigned char*)ACT, vcu, G, tid); flag_arrive(CNT(0), tid);
        { pg8::Gemm g{ACT, Wd1, MP, DM, DFF / 2, DFF / 2}; pg8::StaticOrder S; S.init(MP, DM, G, bx); pg8::EpiResidB<false> E{karg_in<0>(), XB, MOD + 2 * 1024, 0.5f * INV_D};
        pg8::gemm_phase<pg8::EpiResidB<false>, pg8::StaticOrder, true, true, true>(L, g, S, E); }
        flag_wait(CNT(0), (unsigned)G, tid);
        { pg8::Gemm g{ACT, Wd1, MS, DM, opq(128), DFF / 2}; pg8::SplitOrder S; S.init(2, DM, 11, 128, MP / 256, G, vcu); pg8::EpiSlab E{(bf16*)(ws + WS_HST), DM, 128};
        pg8::gemm_phase<pg8::EpiSlab, pg8::SplitOrder, true, true, true>(L, g, S, E); } }
    SEAM(3);
    if (IN(4)) for (int rep_ = 0; rep_ < REPS(4); ++rep_) {
        LAS float* sW = (LAS float*)L;
        for (int i = tid; i < 8192; i += 512) { const int c = i & 7, k = i >> 3; sW[c * 1024 + k] = karg_in<14>()[(size_t)k * INC + 1536 + c]; }
        __syncthreads();
        norm_mod_rows<true, false>(XB, true, karg_in<1>(), false, karg_in<13>(), MOD, 3, 4, H, vcu, G, tid, sW, karg_in<17>(), DT, (const bf16*)(ws + WS_HST), 11, MOD + 2 * 1024, 0.5f * INV_D, XB);
        __syncthreads();
    }
    SEAM(4);
    if (IN(5)) for (int rep_ = 0; rep_ < REPS(5); ++rep_) { { pg8::Gemm g{H, Win, MP, NIN, DM, DM}; pg8::StaticOrder S; S.init(MP, NIN, G, bx);
        pg8::EpiIn E{ws, out, 0.125f * 1.4426950408889634f};
        pg8::gemm_phase<pg8::EpiIn, pg8::StaticOrder, true, true>(L, g, S, E); }
        { pg8::Gemm g{H, Win, MS, NIN, opq(512), DM}; pg8::SplitOrder S; S.init(2, NIN, 2, 512, MP / 256, G, vcu); pg8::EpiSlab E{(bf16*)(ws + WS_HST), NIN, 512};
        pg8::gemm_phase<pg8::EpiSlab, pg8::SplitOrder, true, true>(L, g, S, E); } }
    SEAM(5);
    if (IN(6)) { finish_in((const bf16*)(ws + WS_HST), ws, out, 0.125f * 1.4426950408889634f, vcu, G, tid); flag_arrive(CNT(1), tid);
        ph_conv(XBC, karg_in<5>(), karg_in<15>(), karg_in<16>(), XT, BN, CN, BT, 0, 512, vcu, G, tid);
        flag_wait(CNT(1), (unsigned)G, tid);
        ph_conv(XBC, karg_in<5>(), karg_in<15>(), karg_in<16>(), XT, BN, CN, BT, 512, NCH, vcu, G, tid); }
    SEAM(6);
    if (IN(7)) for (int rep_ = 0; rep_ < REPS(7); ++rep_) { ph_ssd_scan(DT, XT, BT, HST, karg_in<4>(), karg_in<18>(), out + O_SSMP, out + O_SSMS, L, vcu, G, tid); }
    if (IN(7)) { __syncthreads();
        { const float lam = MISC[0];
        for (int v = vcu; v < 256; v += G) {
            const int bh = v >> 3, s = v & 7, b = bh >> 2, hd = bh & 3;
            int ring0 = 0; bool primed = false;
            for (int i = 0; i < 8; ++i) { const int qb = (i >> 2) ? 15 - s : s, j = (i >> 1) & 1, vh = i & 1;
                const bf16* Qp = Qb + (size_t)(b * 4096 + qb * 256) * 512 + (hd * 2 + j) * 64; const bf16* Kp = Kb + (size_t)(b * 4096) * 512 + (hd * 2 + j) * 64; const bf16* Vp = Vb + (size_t)(b * 4096) * 512 + (hd * 2 + vh) * 64;
                bf16* Op = ATTO + (size_t)(b * 4096 + qb * 256) * 1024 + ((hd * 2 + j) * 2 + vh) * 64;
                bf16* Mp = ((i & 3) == 3) ? H + (size_t)(b * 4096 + qb * 256) * 1024 + 512 + hd * 128 : nullptr;
                const bool more = i < 7; const int jn = ((i + 1) >> 1) & 1, vn = (i + 1) & 1;
                const bf16* nK = Kb + (size_t)(b * 4096) * 512 + (hd * 2 + jn) * 64; const bf16* nV = Vb + (size_t)(b * 4096) * 512 + (hd * 2 + vn) * 64;
                ring0 = attn_body::attn_unit<8, false>((const attn_body::bf16*)Qp, (const attn_body::bf16*)Kp, (const attn_body::bf16*)Vp, (attn_body::bf16*)Op, 4 * (qb + 1), -1, (char*)lds, ring0, primed,
                                                       more ? (const attn_body::bf16*)nK : nullptr, more ? (const attn_body::bf16*)nV : nullptr, (attn_body::bf16*)Mp, lam); primed = more; }
        } }
        for (int v = vcu; v < 128; v += G) {
            const int grp = v, vh = grp & 1, j = (grp >> 1) & 1, hd = (grp >> 2) & 3, sb = grp >> 4;
            const bf16* Qp = Qb + (size_t)(MP + sb * 256) * 512 + (hd * 2 + j) * 64; const bf16* Kp = KS + (size_t)(sb * 2176) * 512 + (hd * 2 + j) * 64; const bf16* Vp = VS + (size_t)(sb * 2176) * 512 + (hd * 2 + vh) * 64;
            bf16* Op = ATTOS + (size_t)(sb * 256) * 1024 + ((hd * 2 + j) * 2 + vh) * 64;
            attn_body::attn_unit<8, true>((const attn_body::bf16*)Qp, (const attn_body::bf16*)Kp, (const attn_body::bf16*)Vp, (attn_body::bf16*)Op, 34, 2, (char*)lds, 0, false, nullptr, nullptr, nullptr, 0.f);
        }
    }
    SEAM(7);
    if (IN(8)) for (int rep_ = 0; rep_ < REPS(8); ++rep_) { ph_ssd_out(DT, XT, BN, CN, HST, Zb, karg_in<18>(), karg_in<19>(), karg_in<20>(), H, L, vcu, G, tid); }
    if (IN(8)) { ph_combine(ATTO, ATTOS, MISC, H, vcu, G, tid, MP); }
    SEAM(8);
    if (IN(11)) { { pg8::Gemm g{H, Wout, MP, DM, DM, DM}; pg8::StaticOrder S; S.init(MP, DM, G, bx); pg8::EpiResidB<true> E{XB, XB, MOD + 5 * 1024, 1.0f};
        pg8::gemm_phase<pg8::EpiResidB<true>, pg8::StaticOrder, true, true>(L, g, S, E); }
        { pg8::Gemm g{H, Wout, MS, DM, opq(512), DM}; pg8::SplitOrder S; S.init(2, DM, 2, 512, MP / 256, G, vcu); pg8::EpiSlab E{(bf16*)(ws + WS_XT + 48 * MiB), DM, 512};
        pg8::gemm_phase<pg8::EpiSlab, pg8::SplitOrder, true, true>(L, g, S, E); } }
    SEAM(11);
    if (IN(12)) for (int rep_ = 0; rep_ < REPS(12); ++rep_) { norm_mod_rows<false, true>(XB, true, XB + (size_t)MP * DM, true, karg_in<26>(), MOD, 6, 7, H, vcu, G, tid, nullptr, nullptr, nullptr, (const bf16*)(ws + WS_XT + 48 * MiB), 2, MOD + 5 * 1024, 1.0f, X3); }
    SEAM(12);
    if (IN(13)) { { pg8::Gemm g{H, Wgu2, MP, NGU, DM / 2, DM / 2}; pg8::StaticOrder S; S.init(MP, NGU, G, bx); pg8::EpiSwiGLU E{(unsigned char*)ACT, DFF, INV_GU, SC_ACT8};
        pg8::gemm_phase<pg8::EpiSwiGLU, pg8::StaticOrder, true, true, true>(L, g, S, E); }
        { pg8::Gemm g{H, Wgu2, MS, NGU, opq(256), DM / 2}; pg8::SplitOrder S; S.init(2, NGU, 2, 256, MP / 256, G, vcu); pg8::EpiSlab E{(bf16*)(ws + WS_XT), NGU, 256};
        pg8::gemm_phase<pg8::EpiSlab, pg8::SplitOrder, true, true, true>(L, g, S, E); } }
    SEAM(13);
    if (IN(14)) { finish_gu((const bf16*)(ws + WS_XT), (unsigned char*)ACT, vcu, G, tid); flag_arrive(CNT(2), tid);
        { pg8::Gemm g{ACT, Wd2, MP, DM, DFF / 2, DFF / 2}; pg8::StaticOrder S; S.init(MP, DM, G, bx); pg8::EpiResidB<true> E{XB, X3, MOD + 8 * 1024, 0.5f * INV_D};
        pg8::gemm_phase<pg8::EpiResidB<true>, pg8::StaticOrder, true, true, true>(L, g, S, E); }
        flag_wait(CNT(2), (unsigned)G, tid);
        { pg8::Gemm g{ACT, Wd2, MS, DM, opq(128), DFF / 2}; pg8::SplitOrder S; S.init(2, DM, 11, 128, MP / 256, G, vcu); pg8::EpiSlab E{(bf16*)(ws + WS_HST), DM, 128};
        pg8::gemm_phase<pg8::EpiSlab, pg8::SplitOrder, true, true, true>(L, g, S, E); } }
    SEAM(14);
    if (IN(15)) { ph_final(X3, out, karg_in<29>(), vcu, G, tid, (const bf16*)(ws + WS_HST), 11, MOD + 8 * 1024, 0.5f * INV_D); }
#undef IN
#undef SEAM
}

#ifndef MK_PER_PHASE
#define MK_PER_PHASE 0
#endif
extern "C" void kernel_launch(void* const* d_in, const int* in_sizes, int n_in, void* d_out, int out_size, void* d_ws, size_t ws_size, hipStream_t stream) {
    static int grid = 0;
    if (grid == 0) {
        if (n_in != 30 || (size_t)out_size != O_TOTAL || ws_size < WS_END) { fprintf(stderr, "kernel_launch: unexpected shapes (n_in %d out %d ws %zu)\n", n_in, out_size, ws_size); grid = -1; return; }
        int dev = 0, cus = 0, per_cu = 0;
        if (hipGetDevice(&dev) != hipSuccess || hipDeviceGetAttribute(&cus, hipDeviceAttributeMultiprocessorCount, dev) != hipSuccess) { grid = -1; return; }
        if (hipFuncSetAttribute((const void*)mk_fwd, hipFuncAttributeMaxDynamicSharedMemorySize, LDS_BYTES) != hipSuccess) { fprintf(stderr, "kernel_launch: hipFuncSetAttribute failed\n"); grid = -1; return; }
        if (hipOccupancyMaxActiveBlocksPerMultiprocessor(&per_cu, (const void*)mk_fwd, NWAVES * 64, LDS_BYTES) != hipSuccess || per_cu < 1) { fprintf(stderr, "kernel_launch: occupancy query says %d\n", per_cu); per_cu = 1; }
        (void)hipGetLastError();
        grid = cus * 1;
    }
    if (grid < 0) return;
    Args a{};
    for (int i = 0; i < 30; ++i) a.in[i] = (const float*)d_in[i];
    a.out = (float*)d_out; a.ws = (unsigned char*)d_ws;
#if MK_PER_PHASE
    for (int ph = 0; ph < N_PHASES; ++ph) { a.ph_lo = ph; a.ph_hi = ph + 1; a.coop = 0;
        hipLaunchKernelGGL(mk_fwd, dim3(grid), dim3(NWAVES * 64), LDS_BYTES, stream, a); }
#else
    if (hipMemsetAsync((char*)d_ws + WS_CTL, 0, CTL_ZERO_BYTES, stream) != hipSuccess) { fprintf(stderr, "kernel_launch: memset failed\n"); return; }
    a.ph_lo = 0; a.ph_hi = N_PHASES; a.coop = 1;
    void* kargs[] = {&a};
    hipError_t e = hipLaunchCooperativeKernel((const void*)mk_fwd, dim3(grid), dim3(NWAVES * 64), kargs, LDS_BYTES, stream);
    if (e != hipSuccess) fprintf(stderr, "kernel_launch: cooperative launch failed: %s (grid %d)\n", hipGetErrorString(e), grid);
#endif
}
```

```cpp
#include <hip/hip_runtime.h>
#include <hip/hip_cooperative_groups.h>
#include <cstdio>
#include <cstdint>
constexpr int NWAVES = 8;
constexpr int DM = 1024, MP = 32768, MS = 512, MT = MP + MS, DFF = 2816, NGU = 2 * DFF, NIN = 3072, INC = 3080, NCH = 520;
constexpr float EPSN = 1e-6f;
constexpr int N_PHASES = 16;
constexpr size_t O_Y = 0, O_NKP = 34078720, O_NVP = 50855936, O_SSMP = 67633152, O_CONVP = 68157440, O_NKS = 68182016, O_NVS = 68444160, O_SSMS = 68706304, O_CONVS = 69230592, O_TOTAL = 69255168;
constexpr size_t MiB = 1u << 20;
constexpr size_t WS_CTL = 0, CTL_ZERO_BYTES = 64 * 1024;
constexpr size_t WS_MOD = 1 * MiB, WS_MISC = 1 * MiB + 640 * 1024, WS_DT = 2 * MiB;
constexpr size_t WS_WGU1 = 4 * MiB, WS_WD1 = 15 * MiB, WS_WIN = 21 * MiB, WS_WOUT = 27 * MiB, WS_WGU2 = 29 * MiB, WS_WD2 = 40 * MiB;
constexpr size_t WS_H = 46 * MiB, WS_ACT = 111 * MiB;
constexpr size_t WS_XBC = 111 * MiB, WS_Z = 176 * MiB, WS_Q = 209 * MiB, WS_K = 243 * MiB;
constexpr size_t WS_V = 290 * MiB, WS_KS = 322 * MiB, WS_VS = 339 * MiB, WS_XT = 356 * MiB, WS_BN = 389 * MiB, WS_CN = 406 * MiB, WS_BT = 423 * MiB, WS_HST = 440 * MiB;
constexpr size_t WS_ATTO = 111 * MiB  , WS_ATTOS = 505 * MiB, WS_END = 509 * MiB;
static_assert(WS_ACT + (size_t)MT * DFF * 2 <= WS_V && WS_K + (size_t)MP * 512 * 2 <= WS_V && WS_HST + (size_t)NCH * 8 * 64 * 128 * 2 <= WS_ATTOS, "ws map");
constexpr int LDS_BYTES = 147456;

constexpr float SC_H8 = 8.0f, SC_WGU8 = 64.0f, SC_ACT8 = 4.0f, SC_WD8 = 128.0f;
constexpr float INV_GU = 1.0f / (SC_H8 * SC_WGU8), INV_D = 1.0f / (SC_ACT8 * SC_WD8);
__device__ __forceinline__ float clamp8(float x) { return __builtin_amdgcn_fmed3f(x, -448.0f, 448.0f); }
__device__ __forceinline__ unsigned pk4_fp8(float a, float b, float c, float d) {
    int w = __builtin_amdgcn_cvt_pk_fp8_f32(clamp8(a), clamp8(b), 0, false); w = __builtin_amdgcn_cvt_pk_fp8_f32(clamp8(c), clamp8(d), w, true); return (unsigned)w; }
namespace pg8 {
#define PG8_LAS __attribute__((address_space(3)))
typedef unsigned short bf16_t;
typedef short bf16x8 __attribute__((ext_vector_type(8)));
typedef float f32x4 __attribute__((ext_vector_type(4)));
typedef unsigned u32x4 __attribute__((ext_vector_type(4)));
typedef int i32x4_t __attribute__((ext_vector_type(4)));
constexpr int BM = 256, BK = 64, HALF = 128, HTB = HALF * BK * 2  , STAGE_BYTES = 8 * HTB, NXCD = 8, WGM = 8;

__host__ __device__ __forceinline__ int lds_byte(int r, int c) { const int st = (r >> 4) * 2 + (c >> 5), rr = r & 15, cc = c & 31, ob = rr * 64 + cc * 2; return st * 1024 + (ob ^ (((ob >> 9) & 1) << 5)); }
__host__ __device__ __forceinline__ void stage_rc(int b, int& R, int& C) { const int st = b / 1024, sb = b % 1024, swz = sb ^ (((sb >> 9) & 1) << 5); R = (st >> 1) * 16 + swz / 64; C = (st & 1) * 32 + (swz % 64) / 2; }
__host__ __device__ __forceinline__ int perm32(int rho) { const int n = rho >> 4, i = rho & 15; return 8 * (i >> 2) + 4 * n + (i & 3); }

struct Unit { int pm, pn, kofs; };
struct Gemm { const bf16_t* A; const bf16_t* Bt; int M, N, K, ld; };

struct StaticOrder {
    int nM, nN, nwg, G, c;
    __host__ __device__ void init(int M, int N, int G_, int c_) { nM = M / BM; nN = N / BM; nwg = nM * nN; G = G_; c = c_; }
    __host__ __device__ bool next(int i, Unit& u) const {
        const long L = (long)i * G + c; if (L >= nwg) return false;
        int wgid = (int)L; { const int q = nwg / NXCD, r = nwg % NXCD, xcd = wgid % NXCD, off = wgid / NXCD; wgid = (xcd < r ? xcd * (q + 1) : r * (q + 1) + (xcd - r) * q) + off; }
        const int nig = WGM * nN, gid = wgid / nig, fm = gid * WGM, gsz = (nM - fm) < WGM ? (nM - fm) : WGM;
        u.pm = fm + ((wgid % nig) % gsz); u.pn = (wgid % nig) / gsz; u.kofs = 0; return true;
    }
    __device__ __forceinline__ void a_ready(const Unit&) const {}
    __device__ __forceinline__ void done(const Unit&) const {}
};

struct SplitOrder {
    int nN, S, kchunk, pm0, nunits, G, c;
    __host__ __device__ void init(int nM, int N, int S_, int kchunk_, int pm0_, int G_, int c_) { nN = N / BM; S = S_; kchunk = kchunk_; pm0 = pm0_; nunits = nM * nN * S_; G = G_; c = c_; }
    __host__ __device__ bool next(int i, Unit& u) const {
        const int L = i * G + c; if (L >= nunits) return false;
        const int ks = L % S, t = L / S; u.pn = t % nN; u.pm = pm0 + t / nN; u.kofs = ks * kchunk; return true;
    }
    __device__ __forceinline__ void a_ready(const Unit&) const {}
    __device__ __forceinline__ void done(const Unit&) const {}
};

__device__ __forceinline__ unsigned cvt_pk_bf16(float lo, float hi) { unsigned r; asm volatile("v_cvt_pk_bf16_f32 %0, %1, %2" : "=v"(r) : "v"(lo), "v"(hi)); return r; }
typedef float f32x2 __attribute__((ext_vector_type(2)));
__device__ __forceinline__ const char* uni_ptr(const char* p) { const unsigned long long v = (unsigned long long)p; const unsigned lo = __builtin_amdgcn_readfirstlane((unsigned)v), hi = __builtin_amdgcn_readfirstlane((unsigned)(v >> 32)); return (const char*)(((unsigned long long)hi << 32) | lo); }
__device__ __forceinline__ void glds_s(const char* sbase, unsigned voff, unsigned lds_dst) { unsigned keep;
    asm volatile("s_mov_b32 %0, m0\n\ts_mov_b32 m0, %3\n\ts_nop 0\n\tglobal_load_lds_dwordx4 %1, %2\n\ts_mov_b32 m0, %0" : "=&s"(keep) : "v"(voff), "s"(sbase), "s"(lds_dst) : "memory"); }
typedef int i32x8_t __attribute__((ext_vector_type(8)));
template <bool F8> struct FragT { typedef bf16x8 A[4][2]; typedef bf16x8 B[2][2]; };
template <> struct FragT<true> { typedef i32x8_t A[4]; typedef i32x8_t B[2]; };
template <class Epi, class Sched, bool ALIGN_EPI = false, bool SP2 = false, bool F8 = false>
__device__ __forceinline__ void gemm_phase(PG8_LAS unsigned char* lds, const Gemm g, const Sched& S, const Epi& E) {
    int tid_ = threadIdx.x; asm volatile("" : "+v"(tid_));
    const int tid = tid_, wid = __builtin_amdgcn_readfirstlane(tid >> 6), lane = tid & 63, wr = wid >> 2, wc = wid & 3, fr = lane & 15, fq = lane >> 4;
    const int K = g.K, nt = K / BK;
    unsigned voffA, voffB;
    { int R, C; stage_rc(tid * 16, R, C); const int Rb = Epi::PERM ? ((R & ~31) + perm32(R & 31)) : R;
        voffA = (unsigned)(R * g.ld + C) * 2u; voffB = (unsigned)(Rb * g.ld + C) * 2u; }
    const size_t pstep = (size_t)64 * g.ld * 2;
    const size_t kstep = (size_t)(BK * 2);
    const size_t hstep = (size_t)HALF * g.ld * 2;
    const size_t tstep = 2 * hstep;
    const unsigned ldsbase = (unsigned)(size_t)lds;
    const unsigned ldsw = (unsigned)wid * 1024u;
    const int aoff = lds_byte(wr * 64 + fr, fq * 8), boff = lds_byte(wc * 32 + fr, fq * 8);
#define PG8_SA(b, h) (((b) * 2 + (h)) * HTB)
#define PG8_SB(b, h) ((4 + (b) * 2 + (h)) * HTB)
#define PG8_STAGE(bufoff, gbase, voff) do { const char* gb0_ = uni_ptr((const char*)(gbase)); const char* gb1_ = uni_ptr((const char*)(gbase) + pstep);     \
        __builtin_amdgcn_global_load_lds((const unsigned*)(gb0_ + (voff)), (PG8_LAS unsigned*)(lds + (bufoff) + ldsw), 16, 0, 0); \
        __builtin_amdgcn_global_load_lds((const unsigned*)(gb1_ + (voff)), (PG8_LAS unsigned*)(lds + (bufoff) + ldsw + 8192), 16, 0, 0); } while (0)
#define PG8_CAT(lo, hi) __builtin_shufflevector(__builtin_bit_cast(i32x4_t, lo), __builtin_bit_cast(i32x4_t, hi), 0, 1, 2, 3, 4, 5, 6, 7)
#define PG8_LDA(dst, b, h) do { _Pragma("unroll") for (int m = 0; m < 4; ++m) { if constexpr (F8) { dst[m] = PG8_CAT(*(const PG8_LAS bf16x8*)(lds + PG8_SA(b, h) + aoff + m * 2048), *(const PG8_LAS bf16x8*)(lds + PG8_SA(b, h) + aoff + m * 2048 + 1024)); } \
        else { _Pragma("unroll") for (int k = 0; k < 2; ++k) dst[m][k] = *(const PG8_LAS bf16x8*)(lds + PG8_SA(b, h) + aoff + m * 2048 + k * 1024); } } } while (0)
#define PG8_LDB(dst, b, h) do { _Pragma("unroll") for (int n = 0; n < 2; ++n) { if constexpr (F8) { dst[n] = PG8_CAT(*(const PG8_LAS bf16x8*)(lds + PG8_SB(b, h) + boff + n * 2048), *(const PG8_LAS bf16x8*)(lds + PG8_SB(b, h) + boff + n * 2048 + 1024)); } \
        else { _Pragma("unroll") for (int k = 0; k < 2; ++k) dst[n][k] = *(const PG8_LAS bf16x8*)(lds + PG8_SB(b, h) + boff + n * 2048 + k * 1024); } } } while (0)
#define PG8_MMA(ai, bj, At, Bt) do { __builtin_amdgcn_s_setprio(1); _Pragma("unroll") for (int m = 0; m < 4; ++m) _Pragma("unroll") for (int n = 0; n < 2; ++n) { \
        if constexpr (F8) { acc[ai][bj][m][n] = __builtin_amdgcn_mfma_scale_f32_16x16x128_f8f6f4(Bt[n], At[m], acc[ai][bj][m][n], 0, 0, 0, 0x7F7F7F7F, 0, 0x7F7F7F7F); } \
        else { _Pragma("unroll") for (int k = 0; k < 2; ++k) acc[ai][bj][m][n] = __builtin_amdgcn_mfma_f32_16x16x32_bf16(Bt[n][k], At[m][k], acc[ai][bj][m][n], 0, 0, 0); } } __builtin_amdgcn_s_setprio(0); } while (0)
#define PG8_WAIT_V(n) asm volatile("s_waitcnt vmcnt(" #n ")" ::: "memory")
#define PG8_WAIT_L(n) asm volatile("s_waitcnt lgkmcnt(" #n ")" ::: "memory")
#define PG8_BAR __builtin_amdgcn_s_barrier()
#define PG8_SCHED __builtin_amdgcn_sched_barrier(0)
    Unit cur, nxt; int ui = 0;
    if (!S.next(0, cur)) return;
    f32x4 acc[2][2][4][2];
#pragma unroll
    for (int a = 0; a < 2; ++a)
#pragma unroll
        for (int b = 0; b < 2; ++b)
#pragma unroll
            for (int m = 0; m < 4; ++m)
#pragma unroll
                for (int n = 0; n < 2; ++n) acc[a][b][m][n] = (f32x4){0.f, 0.f, 0.f, 0.f};
    typename FragT<F8>::A At; typename FragT<F8>::B B0, B1;
    const char* cA = (const char*)g.A + (size_t)cur.pm * tstep + (size_t)cur.kofs * 2; const char* cB = (const char*)g.Bt + (size_t)cur.pn * tstep + (size_t)cur.kofs * 2;
    S.a_ready(cur);
    if constexpr (SP2) {
        PG8_STAGE(PG8_SB(0, 0), cB, voffB); PG8_STAGE(PG8_SB(0, 1), cB + hstep, voffB); PG8_STAGE(PG8_SA(0, 0), cA, voffA); PG8_STAGE(PG8_SA(0, 1), cA + hstep, voffA);
        if (wr == 1) PG8_BAR;
        PG8_WAIT_V(2); PG8_BAR;
        PG8_STAGE(PG8_SB(1, 0), cB + kstep, voffB); PG8_STAGE(PG8_SA(1, 0), cA + kstep, voffA); PG8_STAGE(PG8_SB(1, 1), cB + hstep + kstep, voffB);
        PG8_WAIT_V(6); PG8_BAR;
    } else {
        PG8_STAGE(PG8_SB(0, 0), cB, voffB); PG8_STAGE(PG8_SA(0, 0), cA, voffA); PG8_STAGE(PG8_SB(0, 1), cB + hstep, voffB); PG8_STAGE(PG8_SA(0, 1), cA + hstep, voffA);
        if (wr == 1) PG8_BAR;
        PG8_WAIT_V(4); PG8_BAR;
        PG8_STAGE(PG8_SB(1, 0), cB + kstep, voffB); PG8_STAGE(PG8_SA(1, 0), cA + kstep, voffA); PG8_STAGE(PG8_SB(1, 1), cB + hstep + kstep, voffB);
        PG8_WAIT_V(6); PG8_BAR;
    }
    for (;;) {
        const bool has_next = S.next(ui + 1, nxt);
        const char* nA = has_next ? (const char*)g.A + (size_t)nxt.pm * tstep + (size_t)nxt.kofs * 2 : cA; const char* nB = has_next ? (const char*)g.Bt + (size_t)nxt.pn * tstep + (size_t)nxt.kofs * 2 : cB;
#pragma nounroll
        for (int t = 0; t < nt; t += 2) {
            const bool last = (t == nt - 2);
            const char* a1 = cA + (size_t)(t + 1) * kstep;
            const char* a2 = last ? nA : cA + (size_t)(t + 2) * kstep; const char* b2 = last ? nB : cB + (size_t)(t + 2) * kstep;
            const char* a3 = a2 + kstep; const char* b3 = b2 + kstep;
            if (last && has_next) S.a_ready(nxt);
            if constexpr (SP2) {
            PG8_LDB(B0, 0, 0); PG8_LDB(B1, 0, 1); PG8_SCHED; PG8_LDA(At, 0, 0); PG8_STAGE(PG8_SA(1, 1), a1 + hstep, voffA);
            PG8_WAIT_V(8); PG8_WAIT_L(0); PG8_BAR; PG8_MMA(0, 0, At, B0); PG8_MMA(0, 1, At, B1); PG8_BAR; PG8_SCHED;
            PG8_LDA(At, 0, 1); PG8_STAGE(PG8_SB(0, 0), b2, voffB); PG8_STAGE(PG8_SB(0, 1), b2 + hstep, voffB); PG8_STAGE(PG8_SA(0, 0), a2, voffA);
            PG8_WAIT_V(8); PG8_WAIT_L(0); PG8_BAR; PG8_MMA(1, 0, At, B0); PG8_MMA(1, 1, At, B1); PG8_BAR; PG8_SCHED;
            PG8_LDB(B0, 1, 0); PG8_LDB(B1, 1, 1); PG8_SCHED; PG8_LDA(At, 1, 0); PG8_STAGE(PG8_SA(0, 1), a2 + hstep, voffA);
            PG8_WAIT_V(8); PG8_WAIT_L(0); PG8_BAR; PG8_MMA(0, 0, At, B0); PG8_MMA(0, 1, At, B1); PG8_BAR; PG8_SCHED;
            PG8_LDA(At, 1, 1); PG8_STAGE(PG8_SB(1, 0), b3, voffB); PG8_STAGE(PG8_SB(1, 1), b3 + hstep, voffB); PG8_STAGE(PG8_SA(1, 0), a3, voffA);
            PG8_WAIT_V(8); PG8_WAIT_L(0); PG8_BAR; PG8_MMA(1, 0, At, B0); PG8_MMA(1, 1, At, B1); PG8_BAR; PG8_SCHED;
            } else {
            PG8_LDB(B0, 0, 0); PG8_SCHED; PG8_LDA(At, 0, 0); PG8_STAGE(PG8_SA(1, 1), a1 + hstep, voffA);
            PG8_WAIT_L(8); PG8_BAR; PG8_WAIT_L(0); PG8_MMA(0, 0, At, B0); PG8_BAR; PG8_SCHED;
            PG8_LDB(B1, 0, 1); PG8_STAGE(PG8_SB(0, 0), b2, voffB);
            PG8_BAR; PG8_WAIT_L(0); PG8_MMA(0, 1, At, B1); PG8_BAR;
            PG8_LDA(At, 0, 1); PG8_STAGE(PG8_SA(0, 0), a2, voffA);
            PG8_BAR; PG8_WAIT_L(0); PG8_MMA(1, 0, At, B0); PG8_BAR; PG8_SCHED;
            PG8_STAGE(PG8_SB(0, 1), b2 + hstep, voffB);
            PG8_WAIT_V(6); PG8_BAR; PG8_MMA(1, 1, At, B1); PG8_BAR;
            PG8_LDB(B0, 1, 0); PG8_SCHED; PG8_LDA(At, 1, 0); PG8_STAGE(PG8_SA(0, 1), a2 + hstep, voffA);
            PG8_WAIT_L(8); PG8_BAR; PG8_WAIT_L(0); PG8_MMA(0, 0, At, B0); PG8_BAR; PG8_SCHED;
            PG8_LDB(B1, 1, 1); PG8_STAGE(PG8_SB(1, 0), b3, voffB);
            PG8_BAR; PG8_WAIT_L(0); PG8_MMA(0, 1, At, B1); PG8_BAR;
            PG8_LDA(At, 1, 1); PG8_STAGE(PG8_SA(1, 0), a3, voffA);
            PG8_BAR; PG8_WAIT_L(0); PG8_MMA(1, 0, At, B0); PG8_BAR; PG8_SCHED;
            PG8_STAGE(PG8_SB(1, 1), b3 + hstep, voffB);
            PG8_WAIT_V(6); PG8_BAR; PG8_MMA(1, 1, At, B1); PG8_BAR;
            }
        }
        if constexpr (ALIGN_EPI) { if (wr == 0) PG8_BAR; }
        if constexpr (!Epi::AFTER_DRAIN) { int t2_ = threadIdx.x; asm volatile("" : "+v"(t2_)); E(acc, cur, wr, wc, t2_ & 15, (t2_ & 63) >> 4); S.done(cur); }
        if (!has_next) break;
#pragma unroll
        for (int a = 0; a < 2; ++a)
#pragma unroll
            for (int b = 0; b < 2; ++b)
#pragma unroll
                for (int m = 0; m < 4; ++m)
#pragma unroll
                    for (int n = 0; n < 2; ++n) acc[a][b][m][n] = (f32x4){0.f, 0.f, 0.f, 0.f};
        cur = nxt; cA = nA; cB = nB; ++ui;
        if constexpr (ALIGN_EPI) { if (wr == 1) PG8_BAR; }
    }
    PG8_WAIT_V(0);
    if constexpr (!ALIGN_EPI) { if (wr == 0) PG8_BAR; }
    PG8_BAR;
    if constexpr (Epi::AFTER_DRAIN) { E.fused(acc, cur, wr, wc, fr, fq, lds, wid, lane); S.done(cur); }
#undef PG8_SA
#undef PG8_SB
#undef PG8_STAGE
#undef PG8_LDA
#undef PG8_LDB
#undef PG8_MMA
#undef PG8_CAT
#undef PG8_WAIT_V
#undef PG8_WAIT_L
#undef PG8_BAR
#undef PG8_SCHED
}
}
#include <hip/hip_bf16.h>
#include <cmath>
namespace attn_body {
using bf16=__hip_bfloat16;
using bf16x8=__attribute__((ext_vector_type(8)))short;
using s16x4=__attribute__((ext_vector_type(4)))short;
using f32x16=__attribute__((ext_vector_type(16)))float;
using u32x4=__attribute__((ext_vector_type(4)))unsigned;
constexpr int D=64,KP=512,OP=1024;
constexpr int NW=8,QBLK=32,QB=QBLK*NW,KVBLK=64;
__device__ __forceinline__ int crow(int r,int hi){return (r&3)+8*(r>>2)+4*hi;}
#define SBAR() __builtin_amdgcn_sched_barrier(0)
__device__ __forceinline__ void cmask(f32x16&p0,f32x16&p1,int jb,int lim){
  const float NEG=-INFINITY;
  if(jb>lim){
  #pragma unroll
  for(int r=0;r<16;++r){p0[r]=NEG;p1[r]=NEG;} }
}

constexpr int NSLOT=3, SLOTB=8192;
constexpr int LDS_K=0, LDS_V=NSLOT*SLOTB, LDS_WS=2*NSLOT*SLOTB, LDS_OST=LDS_WS+NW*64*4, LDS_BYTES=LDS_OST+NW*4096;
constexpr float C2=0.125f*1.4426950408889634f;
__device__ __forceinline__ void glds16(const void*gsrc,unsigned lds_dst){unsigned keep;
  asm volatile("s_mov_b32 %0, m0\n\ts_mov_b32 m0, %2\n\ts_nop 0\n\tglobal_load_lds_dwordx4 %1, off\n\ts_mov_b32 m0, %0":"=&s"(keep):"v"(gsrc),"s"(lds_dst):"memory");}
__device__ __forceinline__ float max3f(float a,float b,float c){float r;asm("v_max3_f32 %0, %1, %2, %3":"=v"(r):"v"(a),"v"(b),"v"(c));return r;}
__device__ __forceinline__ float max2f(float a,float b){float r;asm("v_max_f32_e32 %0, %1, %2":"=v"(r):"v"(a),"v"(b));return r;}
__device__ __forceinline__ float fadd_s(float a,float b){float r;asm("v_add_f32_e32 %0, %1, %2":"=v"(r):"v"(a),"v"(b));return r;}
__device__ __forceinline__ float fsub_s(float a,float b){float r;asm("v_sub_f32_e32 %0, %1, %2":"=v"(r):"v"(a),"v"(b));return r;}
typedef float f32x2_t __attribute__((ext_vector_type(2))); typedef __bf16 bf16x2_t __attribute__((ext_vector_type(2)));
__device__ __forceinline__ unsigned cvtpk_s(float lo,float hi){f32x2_t v={lo,hi};bf16x2_t b=__builtin_convertvector(v,bf16x2_t);return __builtin_bit_cast(unsigned,b);}
#define WAIT_BAR(N) asm volatile("s_waitcnt vmcnt(" #N ") lgkmcnt(0)\n\ts_barrier":::"memory")

__device__ __forceinline__ void qkt(f32x16&p0,f32x16&p1,const char*Kslot,const bf16x8*qr,const f32x16&negm,int r32,int hi){
  const char*kb=Kslot+hi*1024+r32*16;
  #pragma unroll
  for(int d0=0;d0<4;++d0){
    const bf16x8 b0=*reinterpret_cast<const bf16x8*>(kb+d0*2048);
    const bf16x8 b1=*reinterpret_cast<const bf16x8*>(kb+d0*2048+512);
    if(d0==0){p0=__builtin_amdgcn_mfma_f32_32x32x16_bf16(b0,qr[0],negm,0,0,0);p1=__builtin_amdgcn_mfma_f32_32x32x16_bf16(b1,qr[0],negm,0,0,0);}
    else{p0=__builtin_amdgcn_mfma_f32_32x32x16_bf16(b0,qr[d0],p0,0,0,0);p1=__builtin_amdgcn_mfma_f32_32x32x16_bf16(b1,qr[d0],p1,0,0,0);}}
}
typedef __attribute__((address_space(3))) const char* lds_cptr;
typedef short v4i16_t __attribute__((ext_vector_type(4)));
__device__ __forceinline__ void kload8(bf16x8*kf,lds_cptr kp){
  kf[0]=*(const __attribute__((address_space(3))) bf16x8*)(kp);      kf[1]=*(const __attribute__((address_space(3))) bf16x8*)(kp+512);
  kf[2]=*(const __attribute__((address_space(3))) bf16x8*)(kp+2048); kf[3]=*(const __attribute__((address_space(3))) bf16x8*)(kp+2560);
  kf[4]=*(const __attribute__((address_space(3))) bf16x8*)(kp+4096); kf[5]=*(const __attribute__((address_space(3))) bf16x8*)(kp+4608);
  kf[6]=*(const __attribute__((address_space(3))) bf16x8*)(kp+6144); kf[7]=*(const __attribute__((address_space(3))) bf16x8*)(kp+6656);
}
__device__ __forceinline__ void kload2(bf16x8*kf,lds_cptr kp,int j){ kf[2*j]=*(const __attribute__((address_space(3))) bf16x8*)(kp+j*2048); kf[2*j+1]=*(const __attribute__((address_space(3))) bf16x8*)(kp+j*2048+512); }
__device__ __forceinline__ s16x4 vtr(lds_cptr p){ return __builtin_bit_cast(s16x4,__builtin_amdgcn_ds_read_tr16_b64_v4i16((__attribute__((address_space(3))) v4i16_t*)p)); }
__device__ __forceinline__ float rowmax(const f32x16&p0,const f32x16&p1){
  float a=max3f(p0[0],p0[1],p1[0]),b=max3f(p0[2],p0[3],p1[1]);a=max3f(a,p1[2],p1[3]);
  #pragma unroll
  for(int r=4;r<16;r+=4){a=max3f(a,p0[r],p0[r+1]);b=max3f(b,p0[r+2],p0[r+3]);a=max3f(a,p1[r],p1[r+1]);b=max3f(b,p1[r+2],p1[r+3]);}
  const float m=max2f(a,b);
  auto rr=__builtin_amdgcn_permlane32_swap(__float_as_uint(m),__float_as_uint(m),false,false);
  return max2f(__uint_as_float(rr[0]),__uint_as_float(rr[1]));
}
__device__ __forceinline__ void pv(f32x16*o,int vb,bf16x8 pa0,bf16x8 pa1,bf16x8 pa2,bf16x8 pa3){
  #pragma unroll
  for(int d0=0;d0<2;++d0){s16x4 lo[4],hi[4];
    #pragma unroll
    for(int ks=0;ks<4;++ks){
      asm volatile("ds_read_b64_tr_b16 %0,%1 offset:%c2":"=&v"(lo[ks]):"v"(vb),"i"(d0*4096+ks*1024):"memory");
      asm volatile("ds_read_b64_tr_b16 %0,%1 offset:%c2":"=&v"(hi[ks]):"v"(vb),"i"(d0*4096+ks*1024+512):"memory");}
    asm volatile("s_waitcnt lgkmcnt(0)":::"memory");SBAR();
    #define PK(k) (bf16x8){lo[k][0],lo[k][1],lo[k][2],lo[k][3],hi[k][0],hi[k][1],hi[k][2],hi[k][3]}
    o[d0]=__builtin_amdgcn_mfma_f32_32x32x16_bf16(pa0,PK(0),o[d0],0,0,0);
    o[d0]=__builtin_amdgcn_mfma_f32_32x32x16_bf16(pa1,PK(1),o[d0],0,0,0);
    o[d0]=__builtin_amdgcn_mfma_f32_32x32x16_bf16(pa2,PK(2),o[d0],0,0,0);
    o[d0]=__builtin_amdgcn_mfma_f32_32x32x16_bf16(pa3,PK(3),o[d0],0,0,0);
    #undef PK
  }
}

#ifndef ATTN_STORE16
#define ATTN_STORE16(p,v) (*(u32x4*)(p)=(v))
#endif
template<int THRL,bool PART> __device__ __forceinline__ int attn_unit(const bf16*Qb,const bf16*__restrict__ Kh,const bf16*__restrict__ Vh,bf16*Ob,const int NT,const int vlim_in,char*shm,const int s0,const bool primed,const bf16*nKh,const bf16*nVh,bf16*fuseM,const float lam){
  int tid=threadIdx.x; asm volatile("":"+v"(tid));
  const int lane=tid&63,r32=lane&31,hi=lane>>5; const int wid=__builtin_amdgcn_readfirstlane(tid>>6);
  const int vlim=(vlim_in<0)?(wid>>1):vlim_in;
  const bool act=PART?(wid<2):true;
  const bf16*Qw=Qb+(long)(wid*QBLK)*KP;
  const unsigned lds0=(unsigned)(uintptr_t)shm;
  float*wsf=(float*)(shm+LDS_WS)+wid*64;
  const bf16*ksrc=Kh+(long)lane*KP+wid*8;
  const bf16*vsrc=Vh+(long)(16*(wid&3)+(lane>>2))*KP+(wid>>2)*32+(lane&3)*8;
  const unsigned kdst=lds0+LDS_K+wid*1024, vdst=lds0+LDS_V+wid*1024;
  #define DMA_K(t,slot) glds16(ksrc+(long)(t)*KVBLK*KP,(unsigned)__builtin_amdgcn_readfirstlane(kdst+(slot)))
  #define DMA_V(t,slot) glds16(vsrc+(long)(t)*KVBLK*KP,(unsigned)__builtin_amdgcn_readfirstlane(vdst+(slot)))
  const int vb0=(int)(lds0+LDS_V)+((lane>>4)&1)*32+(lane&3)*8+(4*hi+((lane&15)>>2))*64;
  const int s1=(s0==(NSLOT-1)*SLOTB)?0:s0+SLOTB, s2=(s1==(NSLOT-1)*SLOTB)?0:s1+SLOTB;
  const char*Kbase=shm+LDS_K+s0; bf16x8 kf[8];
  const lds_cptr shm3=(lds_cptr)shm; const lds_cptr kp0=shm3+LDS_K+hi*1024+r32*16; const lds_cptr vp0=shm3+LDS_V+((lane>>4)&1)*32+(lane&3)*8+(4*hi+((lane&15)>>2))*64;
  if(!primed){DMA_K(0,s0);DMA_V(0,s0);DMA_K(1,s1);}
  bf16x8 qr[4];
  #pragma unroll
  for(int d0=0;d0<4;++d0)qr[d0]=*reinterpret_cast<const bf16x8*>(&Qw[(long)r32*KP+d0*16+hi*8]);
  float zz_=0.f;asm volatile("":"+v"(zz_));
  float mhat=zz_,l_reg=zz_;f32x16 o[2];
  _Pragma("unroll") for(int r=0;r<16;++r){o[0][r]=zz_;o[1][r]=zz_;}
  f32x16 negm;
  _Pragma("unroll") for(int r=0;r<16;++r)negm[r]=zz_;
  asm volatile("":"+v"(negm));
  #define CMASK(P0,P1,t) do{int jb_=(t)-(NT-4); if(jb_>=0)cmask(P0,P1,jb_,vlim);}while(0)
  bool resc=false;
  #define START(P0,P1) do{ const float rm=rowmax(P0,P1); resc=false; \
    { const float dl=rm; mhat=fadd_s(mhat,dl); \
      _Pragma("unroll") for(int r=0;r<16;++r){P0[r]=fsub_s(P0[r],dl);P1[r]=fsub_s(P1[r],dl);} \
      _Pragma("unroll") for(int r=0;r<16;++r)negm[r]=-mhat; asm volatile("":"+v"(negm)); } \
    _Pragma("unroll") for(int r=0;r<16;++r)P0[r]=__builtin_amdgcn_exp2f(P0[r]); }while(0)
  #define RESC() do{ if(resc){ asm volatile("s_waitcnt lgkmcnt(0)":::"memory"); \
      _Pragma("unroll") for(int d_=0;d_<2;++d_) _Pragma("unroll") for(int r=0;r<16;++r)o[d_][r]*=wsf[crow(r,hi)]; } }while(0)
  f32x16 pA0,pA1,pB0,pB1;
  int sl_prev=s0,sl_cur=s0,sl_next=s1;
  #define ROT() do{sl_prev=sl_cur;sl_cur=sl_next;sl_next=(sl_next==(NSLOT-1)*SLOTB)?0:sl_next+SLOTB;}while(0)
  if(!primed){DMA_K(2,s2);}
  WAIT_BAR(3);
  if(act){
  qkt(pA0,pA1,Kbase,qr,negm,r32,hi);asm volatile("s_nop 15\n\ts_nop 7":"+v"(pA0),"+v"(pA1));CMASK(pA0,pA1,0);
  START(pA0,pA1);
  _Pragma("unroll") for(int r=0;r<16;++r)pA1[r]=__builtin_amdgcn_exp2f(pA1[r]);
  }
  WAIT_BAR(0);
  DMA_K(3,s0);DMA_V(1,s1);
  ROT();
  if(act)kload8(kf,kp0+sl_cur);
  WAIT_BAR(2);
  s16x4 vlo[8],vhi[8]; u32x4 pw0,pw1,pw2,pw3;
  #define PKW(P,B) cvtpk_s(P[B],P[B+1])
  #define PAF(k) __builtin_bit_cast(bf16x8,pw##k)
  #define VFR(i) (bf16x8){vlo[i][0],vlo[i][1],vlo[i][2],vlo[i][3],vhi[i][0],vhi[i][1],vhi[i][2],vhi[i][3]}
  #define PIN(x) asm volatile("":"+v"(x))
  #define MX3(a,b,c) __builtin_fmaxf(__builtin_fmaxf((a),(b)),(c))
  #define GAPA(MF,A0,A1,A2,A3,W0,W1,PW) do{ MF; sacc+=A0; sacc+=A1; sacc+=A2; sacc+=A3; PIN(sacc); W0; W1; PIN(PW); SBAR(); }while(0)
  #define EX(v) __builtin_amdgcn_exp2f(v)
  #define GAPB(MF,X,B) do{ MF; X[B]=EX(X[B]); X[B+1]=EX(X[B+1]); X[B+2]=EX(X[B+2]); X[B+3]=EX(X[B+3]); PIN(X); SBAR(); }while(0)
  #define VRD(i) do{ vlo[i]=vtr(vp_+(((i)>>2)*4096+((i)&3)*1024)); vhi[i]=vtr(vp_+(((i)>>2)*4096+((i)&3)*1024+512)); }while(0)
  #define KRD(G,j) do{ if(G){ kload2(kf,kp0+sl_next,j); SBAR(); } }while(0)
  #define STEP(C0,C1,P0,P1,t,GK,GV,GL) do{ if(act){ SBAR(); \
    const lds_cptr vp_=vp0+sl_prev; \
    VRD(0); SBAR(); float sacc=(P0[0]+P0[1]); \
    GAPA(C0=__builtin_amdgcn_mfma_f32_32x32x16_bf16(kf[0],qr[0],negm,0,0,0), P0[2],P0[3],P0[4],P0[5],     pw0[0]=PKW(P0,0), pw0[1]=PKW(P0,2), pw0); \
    VRD(4); SBAR(); GAPA(C1=__builtin_amdgcn_mfma_f32_32x32x16_bf16(kf[1],qr[0],negm,0,0,0), P0[6],P0[7],P0[8],P0[9],     pw0[2]=PKW(P0,4), pw0[3]=PKW(P0,6), pw0); \
    VRD(1); SBAR(); GAPA(C0=__builtin_amdgcn_mfma_f32_32x32x16_bf16(kf[2],qr[1],C0,0,0,0),   P0[10],P0[11],P0[12],P0[13], pw1[0]=PKW(P0,8), pw1[1]=PKW(P0,10), pw1); \
    VRD(5); SBAR(); GAPA(C1=__builtin_amdgcn_mfma_f32_32x32x16_bf16(kf[3],qr[1],C1,0,0,0),   P0[14],P0[15],P1[0],P1[1],   pw1[2]=PKW(P0,12),pw1[3]=PKW(P0,14), pw1); \
    VRD(2); SBAR(); GAPA(C0=__builtin_amdgcn_mfma_f32_32x32x16_bf16(kf[4],qr[2],C0,0,0,0),   P1[2],P1[3],P1[4],P1[5],     pw2[0]=PKW(P1,0), pw2[1]=PKW(P1,2), pw2); \
    VRD(6); SBAR(); GAPA(C1=__builtin_amdgcn_mfma_f32_32x32x16_bf16(kf[5],qr[2],C1,0,0,0),   P1[6],P1[7],P1[8],P1[9],     pw2[2]=PKW(P1,4), pw2[3]=PKW(P1,6), pw2); \
    VRD(3); SBAR(); GAPA(C0=__builtin_amdgcn_mfma_f32_32x32x16_bf16(kf[6],qr[3],C0,0,0,0),   P1[10],P1[11],P1[12],P1[13], pw3[0]=PKW(P1,8), pw3[1]=PKW(P1,10), pw3); \
    VRD(7); SBAR(); GAPA(C1=__builtin_amdgcn_mfma_f32_32x32x16_bf16(kf[7],qr[3],C1,0,0,0),   P1[14],P1[15],0.f,0.f,       pw3[2]=PKW(P1,12),pw3[3]=PKW(P1,14), pw3); \
    l_reg+=sacc; } \
    if(GK){DMA_K((t)+3,sl_cur);} if(GV){DMA_V((t)+1,sl_next);} \
    if(act){ CMASK(C0,C1,t); \
    { float a=MX3(C0[0],C0[1],C1[0]),b=MX3(C0[2],C0[3],C1[1]); a=MX3(a,C1[2],C1[3]); \
      _Pragma("unroll") for(int r=4;r<16;r+=4){a=MX3(a,C0[r],C0[r+1]);b=MX3(b,C0[r+2],C0[r+3]);a=MX3(a,C1[r],C1[r+1]);b=MX3(b,C1[r+2],C1[r+3]);} \
      float rm=__builtin_fmaxf(a,b); { auto rr=__builtin_amdgcn_permlane32_swap(__float_as_uint(rm),__float_as_uint(rm),false,false); rm=__builtin_fmaxf(__uint_as_float(rr[0]),__uint_as_float(rr[1])); } \
      resc=false; \
      if(__builtin_expect(__any(rm>(float)THRL),0)){ const float dl=__builtin_fmaxf(rm,0.f); mhat+=dl; \
        _Pragma("unroll") for(int r=0;r<16;++r){C0[r]-=dl;C1[r]-=dl;} \
        _Pragma("unroll") for(int r=0;r<16;++r)negm[r]=-mhat; asm volatile("":"+v"(negm)); \
        const float f=__builtin_amdgcn_exp2f(-dl); l_reg*=f; if(hi==0)wsf[r32]=f; resc=true; } } \
    SBAR(); \
    GAPB(o[0]=__builtin_amdgcn_mfma_f32_32x32x16_bf16(PAF(0),VFR(0),o[0],0,0,0), C0,0); \
    GAPB(o[1]=__builtin_amdgcn_mfma_f32_32x32x16_bf16(PAF(0),VFR(4),o[1],0,0,0), C0,4); \
    KRD(GL,0); GAPB(o[0]=__builtin_amdgcn_mfma_f32_32x32x16_bf16(PAF(1),VFR(1),o[0],0,0,0), C0,8); \
    KRD(GL,1); GAPB(o[1]=__builtin_amdgcn_mfma_f32_32x32x16_bf16(PAF(1),VFR(5),o[1],0,0,0), C0,12); \
    KRD(GL,2); GAPB(o[0]=__builtin_amdgcn_mfma_f32_32x32x16_bf16(PAF(2),VFR(2),o[0],0,0,0), C1,0); \
    KRD(GL,3); GAPB(o[1]=__builtin_amdgcn_mfma_f32_32x32x16_bf16(PAF(2),VFR(6),o[1],0,0,0), C1,4); \
    GAPB(o[0]=__builtin_amdgcn_mfma_f32_32x32x16_bf16(PAF(3),VFR(3),o[0],0,0,0), C1,8); \
    GAPB(o[1]=__builtin_amdgcn_mfma_f32_32x32x16_bf16(PAF(3),VFR(7),o[1],0,0,0), C1,12); } \
    }while(0)
  int t=1;
  #undef CMASK
  #define CMASK(P0,P1,t) do{}while(0)
  for(;t+5<NT;t+=2){
    STEP(pB0,pB1,pA0,pA1,t,true,true,true);     WAIT_BAR(2); RESC(); ROT();
    STEP(pA0,pA1,pB0,pB1,t+1,true,true,true);   WAIT_BAR(2); RESC(); ROT();
  }
  #undef CMASK
  #define CMASK(P0,P1,t) do{int jb_=(t)-(NT-4); if(jb_>=0)cmask(P0,P1,jb_,vlim);}while(0)
  #define ENDW(tt) do{ if((tt)+3<NT){WAIT_BAR(2);} else if((tt)+2<NT){WAIT_BAR(1);} else {WAIT_BAR(0);} }while(0)
  for(;t+1<NT;t+=2){
    STEP(pB0,pB1,pA0,pA1,t,(t+3<NT),(t+1<NT),(t+1<NT));       ENDW(t);   RESC(); ROT();
    STEP(pA0,pA1,pB0,pB1,t+1,(t+4<NT),(t+2<NT),(t+2<NT));     ENDW(t+1); RESC(); ROT();
  }
  if(nKh){ const bf16*nks=nKh+(long)lane*KP+wid*8; const bf16*nvs=nVh+(long)(16*(wid&3)+(lane>>2))*KP+(wid>>2)*32+(lane&3)*8;
    const int a0=sl_next, a1=(a0==(NSLOT-1)*SLOTB)?0:a0+SLOTB, a2=(a1==(NSLOT-1)*SLOTB)?0:a1+SLOTB;
    glds16(nks,(unsigned)__builtin_amdgcn_readfirstlane(kdst+a0)); glds16(nvs,(unsigned)__builtin_amdgcn_readfirstlane(vdst+a0));
    glds16(nks+(long)KVBLK*KP,(unsigned)__builtin_amdgcn_readfirstlane(kdst+a1)); glds16(nks+2L*KVBLK*KP,(unsigned)__builtin_amdgcn_readfirstlane(kdst+a2)); }
  STEP(pB0,pB1,pA0,pA1,NT-1,false,false,false); RESC();
  if(act){ float sacc=pB0[0]+pB0[1]; _Pragma("unroll") for(int r=2;r<16;++r)sacc+=pB0[r]; _Pragma("unroll") for(int r=0;r<16;++r)sacc+=pB1[r]; l_reg+=sacc;
    pw0=(u32x4){PKW(pB0,0),PKW(pB0,2),PKW(pB0,4),PKW(pB0,6)};pw1=(u32x4){PKW(pB0,8),PKW(pB0,10),PKW(pB0,12),PKW(pB0,14)};pw2=(u32x4){PKW(pB1,0),PKW(pB1,2),PKW(pB1,4),PKW(pB1,6)};pw3=(u32x4){PKW(pB1,8),PKW(pB1,10),PKW(pB1,12),PKW(pB1,14)};
    SBAR(); pv(o,vb0+sl_cur,PAF(0),PAF(1),PAF(2),PAF(3)); }
  #undef PKW
  #undef PAF
  #undef VFR
  #undef PIN
  #undef MX3
  #undef GAPA
  #undef GAPB
  #undef EX
  #undef VRD
  #undef KRD
  #undef STEP
  #undef ENDW
  if(act){
  {auto rr=__builtin_amdgcn_permlane32_swap(__float_as_uint(l_reg),__float_as_uint(l_reg),false,false);l_reg=__uint_as_float(rr[0])+__uint_as_float(rr[1]);}
  if(hi==0)wsf[32+r32]=l_reg;asm volatile("s_waitcnt lgkmcnt(0)":::"memory");
  float rli[16];
  #pragma unroll
  for(int r=0;r<16;++r)rli[r]=__builtin_amdgcn_rcpf(wsf[32+crow(r,hi)]);
  bf16*Ow=Ob+(long)(wid*QBLK)*OP;
  { bf16*stg=(bf16*)(shm+LDS_OST)+wid*2048;
    #pragma unroll
    for(int r=0;r<16;++r){const int orow=crow(r,hi);
      #pragma unroll
      for(int d0=0;d0<2;++d0)stg[orow*64+d0*32+r32]=__float2bfloat16(o[d0][r]*rli[r]);}
    asm volatile("s_waitcnt lgkmcnt(0)":::"memory");
    if(!fuseM){
    #pragma unroll
    for(int i=0;i<4;++i){const int row=i*8+(lane>>3),ch=lane&7; const u32x4 v=*(const u32x4*)(stg+row*64+ch*8); ATTN_STORE16(Ow+(long)row*OP+ch*8,v);}
    } else {
    asm volatile("s_waitcnt vmcnt(0)":::"memory"); __builtin_amdgcn_fence(__ATOMIC_ACQUIRE,"agent");
    bf16*Mw=fuseM+(long)(wid*QBLK)*OP;
    #pragma unroll
    for(int i=0;i<4;++i){const int row=i*8+(lane>>3),ch=lane&7; const u32x4 v=*(const u32x4*)(stg+row*64+ch*8);
      const bf16*gp=Ow+(long)row*OP+ch*8; const u32x4 a=*(const u32x4*)(gp-192), c1=*(const u32x4*)(gp-128), b=*(const u32x4*)(gp-64);
      float d0[8],d1[8],ss=0.f;
      #pragma unroll
      for(int q=0;q<4;++q){ d0[2*q]=__uint_as_float(a[q]<<16)-lam*__uint_as_float(b[q]<<16); d0[2*q+1]=__uint_as_float(a[q]&0xffff0000u)-lam*__uint_as_float(b[q]&0xffff0000u);
        d1[2*q]=__uint_as_float(c1[q]<<16)-lam*__uint_as_float(v[q]<<16); d1[2*q+1]=__uint_as_float(c1[q]&0xffff0000u)-lam*__uint_as_float(v[q]&0xffff0000u);
        ss+=d0[2*q]*d0[2*q]+d0[2*q+1]*d0[2*q+1]+d1[2*q]*d1[2*q]+d1[2*q+1]*d1[2*q+1]; }
      ss+=__shfl_xor(ss,1); ss+=__shfl_xor(ss,2); ss+=__shfl_xor(ss,4);
      const float rn=rsqrtf(ss*(1.0f/128.0f)+1e-6f)*0.8f;
      u32x4 w0,w1;
      #pragma unroll
      for(int q=0;q<4;++q){ w0[q]=cvtpk_s(d0[2*q]*rn,d0[2*q+1]*rn); w1[q]=cvtpk_s(d1[2*q]*rn,d1[2*q+1]*rn); }
      *(u32x4*)(Mw+(long)row*OP+ch*8)=w0; *(u32x4*)(Mw+(long)row*OP+64+ch*8)=w1; }
    } }
  }
  asm volatile("s_waitcnt lgkmcnt(0)\n\ts_barrier":::"memory");
  #undef DMA_K
  #undef DMA_V
  #undef CMASK
  #undef START
  #undef RESC
  #undef ROT
  return sl_next;
}
constexpr int ATTN_LDS_BYTES=LDS_BYTES;
#undef SBAR
#undef WAIT_BAR
}

namespace pg8 {
constexpr int MPc = 32768;
__device__ __forceinline__ float silu_f(float x) { return x * __builtin_amdgcn_rcpf(1.0f + __builtin_amdgcn_exp2f(-1.4426950408889634f * x)); }
struct EpiSwiGLU {
    static constexpr bool PERM = true, AFTER_DRAIN = false;
    unsigned char* O; int ldc; float inv, oscale;
    __device__ __forceinline__ void operator()(const f32x4 (&acc)[2][2][4][2], const Unit& u, int wr, int wc, int fr, int fq) const {
        const int row0 = u.pm * BM + wr * 64 + fr, col0 = u.pn * HALF + wc * 32 + 8 * fq;
#pragma unroll
        for (int ai = 0; ai < 2; ++ai)
#pragma unroll
            for (int m = 0; m < 4; ++m) { unsigned char* rowp = O + (size_t)(row0 + ai * HALF + m * 16) * ldc + col0;
                const f32x4 g0 = acc[ai][0][m][0] * inv, g1 = acc[ai][0][m][1] * inv, u0 = acc[ai][1][m][0] * (inv * oscale), u1 = acc[ai][1][m][1] * (inv * oscale);
                unsigned w0 = pk4_fp8(silu_f(g0[0]) * u0[0], silu_f(g0[1]) * u0[1], silu_f(g0[2]) * u0[2], silu_f(g0[3]) * u0[3]);
                unsigned w1 = pk4_fp8(silu_f(g1[0]) * u1[0], silu_f(g1[1]) * u1[1], silu_f(g1[2]) * u1[2], silu_f(g1[3]) * u1[3]);
                typedef unsigned u32x2_t __attribute__((ext_vector_type(2))); *(u32x2_t*)rowp = (u32x2_t){w0, w1}; }
    }
};
struct EpiResid {
    static constexpr bool PERM = true, AFTER_DRAIN = false;
    const float* baseP; const float* baseS; float* out; const float* gate; float s;
    __device__ __forceinline__ void operator()(const f32x4 (&acc)[2][2][4][2], const Unit& u, int wr, int wc, int fr, int fq) const {
        const int colb = u.pn * BM + wc * 32 + 8 * fq;
#pragma unroll
        for (int ai = 0; ai < 2; ++ai) {
            const int r0 = u.pm * BM + ai * HALF + wr * 64; const int mb = r0 < MPc ? (r0 >> 12) : 8 + ((r0 - MPc) >> 6);
            f32x4 gv[2][2];
#pragma unroll
            for (int bj = 0; bj < 2; ++bj)
#pragma unroll
                for (int n = 0; n < 2; ++n) gv[bj][n] = *(const f32x4*)(gate + (size_t)mb * 9216 + colb + bj * HALF + 4 * n) * s;
#pragma unroll
            for (int m = 0; m < 4; ++m) { const int row = r0 + m * 16 + fr;
                const float* bp = row < MPc ? baseP + (size_t)row * 1024 : baseS + (size_t)(row - MPc) * 1024; float* op = out + (size_t)row * 1024;
#pragma unroll
                for (int bj = 0; bj < 2; ++bj)
#pragma unroll
                    for (int n = 0; n < 2; ++n) { const int col = colb + bj * HALF + 4 * n; const f32x4 o = *(const f32x4*)(bp + col) + gv[bj][n] * acc[ai][bj][m][n]; *(f32x4*)(op + col) = o; }
            }
        }
    }
};
__device__ __forceinline__ void route_in(unsigned char* ws, float* out, float qscale, int row, int c, f32x4 v0, f32x4 v1) {
    const int pn = c >> 8; const bool smp = row >= MPc; const int sb = (row - MPc) >> 6, ts = row & 63;
    if (pn >= 6 && pn < 8) { v0 = v0 * qscale; v1 = v1 * qscale; }
    u32x4 w; w.x = cvt_pk_bf16(v0[0], v0[1]); w.y = cvt_pk_bf16(v0[2], v0[3]); w.z = cvt_pk_bf16(v1[0], v1[1]); w.w = cvt_pk_bf16(v1[2], v1[3]);
    if (pn < 2) { *(u32x4*)((bf16_t*)(ws + WS_Z) + (size_t)row * 512 + c) = w; }
    else if (pn < 6) { const int cc = c - 512; *(u32x4*)((bf16_t*)(ws + WS_XBC) + (size_t)row * 1024 + cc) = w;
        if (!smp) { const int tt = row & 4095; if (tt >= 4093) { float* p = out + O_CONVP + (size_t)((row >> 12) * 3 + tt - 4093) * 1024 + cc; *(f32x4*)p = v0; *(f32x4*)(p + 4) = v1; } }
        else if (ts >= 61) { float* p = out + O_CONVS + (size_t)(sb * 3 + ts - 61) * 1024 + cc; *(f32x4*)p = v0; *(f32x4*)(p + 4) = v1; } }
    else if (pn < 8) { const int cc = c - 1536; const size_t qrow = smp ? (size_t)(MPc + sb * 256 + ts) : (size_t)row; *(u32x4*)((bf16_t*)(ws + WS_Q) + qrow * 512 + cc) = w; }
    else { const bool isk = pn < 10; const int cc = c - (isk ? 2048 : 2560);
        bf16_t* bp = smp ? (bf16_t*)(ws + (isk ? WS_KS : WS_VS)) + (size_t)(sb * 2176 + 2048 + ts) * 512 + cc : (bf16_t*)(ws + (isk ? WS_K : WS_V)) + (size_t)row * 512 + cc;
        *(u32x4*)bp = w;
        float* fp = smp ? out + (isk ? O_NKS : O_NVS) + (size_t)(row - MPc) * 512 + cc : out + (isk ? O_NKP : O_NVP) + (size_t)row * 512 + cc;
        *(f32x4*)fp = v0; *(f32x4*)(fp + 4) = v1; }
}
struct EpiIn {
    static constexpr bool PERM = true, AFTER_DRAIN = false;
    unsigned char* ws; float* out; float qscale;
    __device__ __forceinline__ void operator()(const f32x4 (&acc)[2][2][4][2], const Unit& u, int wr, int wc, int fr, int fq) const {
        const int colt = u.pn * BM + wc * 32 + 8 * fq;
#pragma unroll
        for (int ai = 0; ai < 2; ++ai)
#pragma unroll
            for (int m = 0; m < 4; ++m) { const int row = u.pm * BM + ai * HALF + wr * 64 + m * 16 + fr;
#pragma unroll
                for (int bj = 0; bj < 2; ++bj) route_in(ws, out, qscale, row, colt + bj * HALF, acc[ai][bj][m][0], acc[ai][bj][m][1]); }
    }
};
struct EpiSlab {
    static constexpr bool PERM = true, AFTER_DRAIN = false;
    bf16_t* slab; int N; int kchunk;
    __device__ __forceinline__ void operator()(const f32x4 (&acc)[2][2][4][2], const Unit& u, int wr, int wc, int fr, int fq) const {
        bf16_t* base = slab + (size_t)(u.kofs / kchunk) * 512 * N; const int colb = u.pn * BM + wc * 32 + 8 * fq;
#pragma unroll
        for (int ai = 0; ai < 2; ++ai)
#pragma unroll
            for (int m = 0; m < 4; ++m) { bf16_t* rp = base + (size_t)(u.pm * BM - MPc + ai * HALF + wr * 64 + m * 16 + fr) * N + colb;
#pragma unroll
                for (int bj = 0; bj < 2; ++bj) { const f32x4 a0 = acc[ai][bj][m][0], a1 = acc[ai][bj][m][1];
                    u32x4 w; w.x = cvt_pk_bf16(a0[0], a0[1]); w.y = cvt_pk_bf16(a0[2], a0[3]); w.z = cvt_pk_bf16(a1[0], a1[1]); w.w = cvt_pk_bf16(a1[2], a1[3]);
                    *(u32x4*)(rp + bj * HALF) = w; } }
    }
};
template <bool BASE_BF16> struct EpiResidB {
    static constexpr bool PERM = true, AFTER_DRAIN = false;
    const void* base; bf16_t* out; const float* gate; float s;
    __device__ __forceinline__ void operator()(const f32x4 (&acc)[2][2][4][2], const Unit& u, int wr, int wc, int fr, int fq) const {
        const int colb = u.pn * BM + wc * 32 + 8 * fq;
#pragma unroll
        for (int ai = 0; ai < 2; ++ai) {
            const int r0 = u.pm * BM + ai * HALF + wr * 64; const int mb = r0 >> 12;
            f32x4 gv[2][2];
#pragma unroll
            for (int bj = 0; bj < 2; ++bj)
#pragma unroll
                for (int n = 0; n < 2; ++n) gv[bj][n] = *(const f32x4*)(gate + (size_t)mb * 9216 + colb + bj * HALF + 4 * n) * s;
#pragma unroll
            for (int m = 0; m < 4; ++m) { const size_t ro = (size_t)(r0 + m * 16 + fr) * 1024;
#pragma unroll
                for (int bj = 0; bj < 2; ++bj) { const int col = colb + bj * HALF; f32x4 b0, b1;
                    if (BASE_BF16) { const u32x4 raw = *(const u32x4*)((const bf16_t*)base + ro + col);
                        b0 = (f32x4){__uint_as_float(raw.x << 16), __uint_as_float(raw.x & 0xffff0000u), __uint_as_float(raw.y << 16), __uint_as_float(raw.y & 0xffff0000u)};
                        b1 = (f32x4){__uint_as_float(raw.z << 16), __uint_as_float(raw.z & 0xffff0000u), __uint_as_float(raw.w << 16), __uint_as_float(raw.w & 0xffff0000u)}; }
                    else { b0 = *(const f32x4*)((const float*)base + ro + col); b1 = *(const f32x4*)((const float*)base + ro + col + 4); }
                    const f32x4 o0 = b0 + gv[bj][0] * acc[ai][bj][m][0], o1 = b1 + gv[bj][1] * acc[ai][bj][m][1];
                    u32x4 w; w.x = cvt_pk_bf16(o0[0], o0[1]); w.y = cvt_pk_bf16(o0[2], o0[3]); w.z = cvt_pk_bf16(o1[0], o1[1]); w.w = cvt_pk_bf16(o1[2], o1[3]);
                    *(u32x4*)(out + ro + col) = w; }
            }
        }
    }
};
struct EpiResidAtomic {
    static constexpr bool PERM = true, AFTER_DRAIN = false;
    float* out; const float* gate; float s;
    __device__ __forceinline__ void operator()(const f32x4 (&acc)[2][2][4][2], const Unit& u, int wr, int wc, int fr, int fq) const {
        const int colb = u.pn * BM + wc * 32 + 8 * fq;
#pragma unroll
        for (int ai = 0; ai < 2; ++ai) {
            const int r0 = u.pm * BM + ai * HALF + wr * 64; const int mb = r0 < MPc ? (r0 >> 12) : 8 + ((r0 - MPc) >> 6);
            f32x4 gv[2][2];
#pragma unroll
            for (int bj = 0; bj < 2; ++bj)
#pragma unroll
                for (int n = 0; n < 2; ++n) gv[bj][n] = *(const f32x4*)(gate + (size_t)mb * 9216 + colb + bj * HALF + 4 * n) * s;
#pragma unroll
            for (int m = 0; m < 4; ++m) { float* op = out + (size_t)(r0 + m * 16 + fr) * 1024 + colb;
#pragma unroll
                for (int bj = 0; bj < 2; ++bj)
#pragma unroll
                    for (int n = 0; n < 2; ++n) { const f32x4 o = gv[bj][n] * acc[ai][bj][m][n]; float* p = op + bj * HALF + 4 * n;
                        unsafeAtomicAdd(p, o[0]); unsafeAtomicAdd(p + 1, o[1]); unsafeAtomicAdd(p + 2, o[2]); unsafeAtomicAdd(p + 3, o[3]); }
            }
        }
    }
};
}

namespace cg = cooperative_groups;
#define GAS __attribute__((address_space(1)))
#define LAS __attribute__((address_space(3)))
typedef unsigned short bf16;
typedef unsigned v4u __attribute__((ext_vector_type(4)));
typedef unsigned v2u __attribute__((ext_vector_type(2)));
typedef float f32x4 __attribute__((ext_vector_type(4)));
typedef short bf16x8 __attribute__((ext_vector_type(8)));
__device__ __forceinline__ float bf2f(unsigned x) { return __uint_as_float(x << 16); }
__device__ __forceinline__ float bflo(unsigned x) { return __uint_as_float(x << 16); }
__device__ __forceinline__ float bfhi(unsigned x) { return __uint_as_float(x & 0xffff0000u); }
__device__ __forceinline__ unsigned pk2(float lo, float hi) { return pg8::cvt_pk_bf16(lo, hi); }
__device__ __forceinline__ float silu_f(float x) { return x * __builtin_amdgcn_rcpf(1.0f + __builtin_amdgcn_exp2f(-1.4426950408889634f * x)); }
__device__ __forceinline__ float wave_sum(float v) {
#pragma unroll
    for (int o = 1; o < 64; o <<= 1) v += __shfl_xor(v, o);
    return v;
}
__device__ __forceinline__ float wave_incl_scan(float a, int lane) {
#pragma unroll
    for (int o = 1; o < 64; o <<= 1) { const float t = __shfl_up(a, o); if (lane >= o) a += t; }
    return a;
}
#define LDS_WAIT() asm volatile("s_waitcnt lgkmcnt(0)" ::: "memory")

__device__ __forceinline__ void ph_mod(const float* cp, const float* cs, const float* w_ada, const float* b_ada, float* MOD, float* MISC,
                                       const float* lq1, const float* lk1, const float* lq2, const float* lk2, LAS unsigned char* lds, int G, int tid) {
    asm volatile("" : "+v"(tid));
    LAS float* scT = (LAS float*)lds;
    LAS float* red = (LAS float*)(lds + 65536);
    const int lane = tid & 63, wave = tid >> 6;
    if ((int)blockIdx.x < 144) for (int i = tid; i < 16384; i += 512) { const int b = i >> 10, k = i & 1023; const float c = b < 8 ? cp[b * 1024 + k] : cs[(b - 8) * 1024 + k]; scT[k * 16 + b] = c / (1.0f + __expf(-c)); }
    __syncthreads();
    for (int unit = blockIdx.x; unit < 144; unit += G) {
        const int col = unit * 64 + lane;
        float acc[16];
#pragma unroll
        for (int b = 0; b < 16; ++b) acc[b] = 0.f;
        const int k0 = wave * 128;
#pragma unroll 16
        for (int kk = 0; kk < 128; ++kk) { const int k = k0 + kk; const float wv = w_ada[(size_t)k * 9216 + col];
            const f32x4 s0 = *(const LAS f32x4*)(scT + k * 16), s1 = *(const LAS f32x4*)(scT + k * 16 + 4), s2 = *(const LAS f32x4*)(scT + k * 16 + 8), s3 = *(const LAS f32x4*)(scT + k * 16 + 12);
            acc[0] += s0[0] * wv; acc[1] += s0[1] * wv; acc[2] += s0[2] * wv; acc[3] += s0[3] * wv; acc[4] += s1[0] * wv; acc[5] += s1[1] * wv; acc[6] += s1[2] * wv; acc[7] += s1[3] * wv;
            acc[8] += s2[0] * wv; acc[9] += s2[1] * wv; acc[10] += s2[2] * wv; acc[11] += s2[3] * wv; acc[12] += s3[0] * wv; acc[13] += s3[1] * wv; acc[14] += s3[2] * wv; acc[15] += s3[3] * wv; }
#pragma unroll
        for (int b = 0; b < 16; ++b) red[(wave * 16 + b) * 64 + lane] = acc[b];
        __syncthreads();
        for (int o = tid; o < 1024; o += 512) { const int b = o >> 6, l = o & 63; float s = 0.f;
#pragma unroll
            for (int w = 0; w < 8; ++w) s += red[(w * 16 + b) * 64 + l];
            MOD[(size_t)b * 9216 + unit * 64 + l] = s + b_ada[unit * 64 + l]; }
        __syncthreads();
    }
    if (blockIdx.x == (unsigned)(G - 1) && wave == 0) { float a = lq1[lane] * lk1[lane], b = lq2[lane] * lk2[lane]; a = wave_sum(a); b = wave_sum(b); if (lane == 0) MISC[0] = __expf(a) - __expf(b) + 0.2f; }
}

template <int MODE> __device__ __forceinline__ int rowmap(int n) {
    if (MODE == 1) { const int f = n < DFF ? n : n - DFF, u = n < DFF ? 0 : 128; return (f >> 7) * 256 + u + (f & 127); }
    if (MODE == 2) { return n < 1536 ? n : (n < 1544 ? -1 : n - 8); }
    return n;
}
template <int MODE, bool F8> __device__ __forceinline__ void transpose_item(const float* W, int K, int N, bf16* WT, LAS float* scr, int item, int lane, float sc) {
    const int nblk = (N + 31) / 32, kb = item / nblk, nb = item % nblk, k0 = 64 * kb, n0 = 32 * nb;
    const int nq = 4 * (lane & 7), nn = n0 + nq;
    f32x4 tv[8];
#pragma unroll
    for (int i = 0; i < 8; ++i) { const int kk = 8 * i + (lane >> 3); tv[i] = nn < N ? *(const f32x4*)(W + (size_t)(k0 + kk) * N + nn) : (f32x4){0.f, 0.f, 0.f, 0.f}; }
#pragma unroll
    for (int i = 0; i < 8; ++i) { const int kk = 8 * i + (lane >> 3); LAS float* d = scr + kk * 33 + nq; d[0] = tv[i][0]; d[1] = tv[i][1]; d[2] = tv[i][2]; d[3] = tv[i][3]; }
    LDS_WAIT(); asm volatile("" ::: "memory");
    const int c = lane & 7;
#pragma unroll
    for (int j = 0; j < 4; ++j) { const int n = (lane >> 3) + 8 * j; const LAS float* s = scr + (8 * c) * 33 + n;
        v4u o; o.x = pk2(s[0 * 33], s[1 * 33]); o.y = pk2(s[2 * 33], s[3 * 33]); o.z = pk2(s[4 * 33], s[5 * 33]); o.w = pk2(s[6 * 33], s[7 * 33]);
        const int r = (n0 + n < N) ? rowmap<MODE>(n0 + n) : -1;
        if (F8) { v2u o8; o8.x = pk4_fp8(s[0 * 33] * sc, s[1 * 33] * sc, s[2 * 33] * sc, s[3 * 33] * sc); o8.y = pk4_fp8(s[4 * 33] * sc, s[5 * 33] * sc, s[6 * 33] * sc, s[7 * 33] * sc);
            if (r >= 0) *(v2u*)((unsigned char*)WT + (size_t)r * K + k0 + 8 * c) = o8; }
        else if (r >= 0) *(v4u*)(WT + (size_t)r * K + k0 + 8 * c) = o; }
    LDS_WAIT(); asm volatile("" ::: "memory");
}

__device__ __forceinline__ void load_row4(const void* base, bool is_bf16, size_t row, int lane, f32x4 (&v)[4]) {
    if (is_bf16) { const v2u* p = (const v2u*)((const bf16*)base + row * DM);
#pragma unroll
        for (int j = 0; j < 4; ++j) { const v2u r = p[lane + 64 * j]; v[j] = (f32x4){bflo(r.x), bfhi(r.x), bflo(r.y), bfhi(r.y)}; } }
    else { const f32x4* p = (const f32x4*)((const float*)base + row * DM);
#pragma unroll
        for (int j = 0; j < 4; ++j) v[j] = p[lane + 64 * j]; }
}
template <bool WITH_DT, bool OUT8> __device__ __forceinline__ void norm_mod_rows(const void* xp, bool pb16, const void* xs, bool sb16, const float* w, const float* MOD, int ish, int isc, bf16* H,
                                                                        int vcu, int G, int tid, const LAS float* sW, const float* dt_bias, float* DT,
                                                                        const bf16* fslab, int fS, const float* fgate, float fsc, bf16* fxout) {
    asm volatile("" : "+v"(tid)); const int lane = tid & 63, gw = vcu * NWAVES + __builtin_amdgcn_readfirstlane(tid >> 6), NGW = G * NWAVES;
    f32x4 wv[4];
#pragma unroll
    for (int j = 0; j < 4; ++j) wv[j] = ((const f32x4*)w)[lane + 64 * j];
    f32x4 wdt[WITH_DT ? 8 : 1][4];
    if (WITH_DT) {
#pragma unroll
        for (int c = 0; c < 8; ++c)
#pragma unroll
            for (int j = 0; j < 4; ++j) wdt[c][j] = *(const LAS f32x4*)(sW + c * 1024 + 4 * (lane + 64 * j)); }
    f32x4 vn[4];
    if (gw < MT) { if (gw < MP) load_row4(xp, pb16, (size_t)gw, lane, vn); else load_row4(xs, sb16, (size_t)(gw - MP), lane, vn); }
    for (int row = gw; row < MT; row += NGW) {
        const int mb = row < MP ? (row >> 12) : 8 + ((row - MP) >> 6);
        f32x4 v[4]; float s = 0.f;
#pragma unroll
        for (int j = 0; j < 4; ++j) v[j] = vn[j];
        { const int rn = row + NGW; if (rn < MT) { if (rn < MP) load_row4(xp, pb16, (size_t)rn, lane, vn); else load_row4(xs, sb16, (size_t)(rn - MP), lane, vn); } }
        if (fslab && row >= MP) {
            f32x4 a[4];
#pragma unroll
            for (int j = 0; j < 4; ++j) a[j] = (f32x4){0.f, 0.f, 0.f, 0.f};
            for (int ks = 0; ks < fS; ++ks) { const v2u* sp = (const v2u*)(fslab + ((size_t)ks * MS + (row - MP)) * DM);
#pragma unroll
                for (int j = 0; j < 4; ++j) { const v2u r = sp[lane + 64 * j]; a[j] += (f32x4){bflo(r.x), bfhi(r.x), bflo(r.y), bfhi(r.y)}; } }
#pragma unroll
            for (int j = 0; j < 4; ++j) { v[j] += ((const f32x4*)(fgate + (size_t)mb * 9216))[lane + 64 * j] * fsc * a[j];
                v2u o; o.x = pk2(v[j][0], v[j][1]); o.y = pk2(v[j][2], v[j][3]); *(v2u*)(fxout + (size_t)row * DM + 4 * (lane + 64 * j)) = o; }
        }
#pragma unroll
        for (int j = 0; j < 4; ++j) s += (v[j][0] * v[j][0] + v[j][1] * v[j][1]) + (v[j][2] * v[j][2] + v[j][3] * v[j][3]);
        const float rstd = rsqrtf(wave_sum(s) * (1.0f / DM) + EPSN);
        const f32x4* sh = (const f32x4*)(MOD + (size_t)mb * 9216 + ish * 1024); const f32x4* sc = (const f32x4*)(MOD + (size_t)mb * 9216 + isc * 1024);
#pragma unroll
        for (int j = 0; j < 4; ++j) { const f32x4 a = v[j] * rstd * wv[j]; v[j] = a * (sc[lane + 64 * j] + 1.0f) + sh[lane + 64 * j];
            if (OUT8) { *(unsigned*)((unsigned char*)H + (size_t)row * DM + 4 * (lane + 64 * j)) = pk4_fp8(v[j][0] * SC_H8, v[j][1] * SC_H8, v[j][2] * SC_H8, v[j][3] * SC_H8); }
            else { v2u o; o.x = pk2(v[j][0], v[j][1]); o.y = pk2(v[j][2], v[j][3]); *(v2u*)(H + (size_t)row * DM + 4 * (lane + 64 * j)) = o; } }
        if (WITH_DT) {
            float d[8];
#pragma unroll
            for (int c = 0; c < 8; ++c) { float p = 0.f;
#pragma unroll
                for (int j = 0; j < 4; ++j) { const f32x4 ww = wdt[WITH_DT ? c : 0][j]; p += (v[j][0] * ww[0] + v[j][1] * ww[1]) + (v[j][2] * ww[2] + v[j][3] * ww[3]); }
                d[c] = p; }
            float e4[4], e2[2], e1;
            { const bool up = (lane & 32) != 0;
#pragma unroll
              for (int c = 0; c < 4; ++c) { const float keep = up ? d[4 + c] : d[c], give = up ? d[c] : d[4 + c]; e4[c] = keep + __shfl_xor(give, 32); } }
            { const bool up = (lane & 16) != 0;
#pragma unroll
              for (int c = 0; c < 2; ++c) { const float keep = up ? e4[2 + c] : e4[c], give = up ? e4[c] : e4[2 + c]; e2[c] = keep + __shfl_xor(give, 16); } }
            { const bool up = (lane & 8) != 0; const float keep = up ? e2[1] : e2[0], give = up ? e2[0] : e2[1]; e1 = keep + __shfl_xor(give, 8); }
            e1 += __shfl_xor(e1, 4); e1 += __shfl_xor(e1, 2); e1 += __shfl_xor(e1, 1);
            const int col = ((lane >> 5) & 1) * 4 + ((lane >> 4) & 1) * 2 + ((lane >> 3) & 1);
            if ((lane & 7) == 0) { const float p = e1 + dt_bias[col]; DT[(size_t)row * 8 + col] = fmaxf(p, 0.f) + log1pf(__expf(-fabsf(p))); }
        }
    }
}

__device__ __forceinline__ void ph_conv(const bf16* XBC, const float* state_conv, const float* conv_w, const float* conv_b, bf16* XT, bf16* BN, bf16* CN, bf16* BT, int c_lo, int c_hi, int vcu, int G, int tid) {
    asm volatile("" : "+v"(tid));
    const int ch = 2 * tid;
    float w0[4], w1[4];
#pragma unroll
    for (int w = 0; w < 4; ++w) { w0[w] = conv_w[w * 1024 + ch]; w1[w] = conv_w[w * 1024 + ch + 1]; }
    const float b0 = conv_b[ch], b1 = conv_b[ch + 1];
#define CONV_LD(itx, dst) do { const int r0_ = ((itx) >> 2) * 64 + ((itx) & 3) * 16; _Pragma("unroll") for (int i = 0; i < 19; ++i) { const int rr_ = r0_ - 3 + i; \
        dst[i] = *(const unsigned*)(XBC + (size_t)(rr_ < 0 ? 0 : rr_) * 1024 + ch); } } while (0)
    unsigned rawn[19];
    if (4 * c_lo + vcu < 4 * c_hi) CONV_LD(4 * c_lo + vcu, rawn);
    for (int it = 4 * c_lo + vcu; it < 4 * c_hi; it += G) {
        const int ci = it >> 2, q = it & 3, row0 = ci * 64 + q * 16; const bool smp = ci >= 512;
        unsigned raw[19];
#pragma unroll
        for (int i = 0; i < 19; ++i) raw[i] = rawn[i];
        if (it + G < 4 * c_hi) CONV_LD(it + G, rawn);
        float p0[3], p1[3];
        if (q == 0 && smp) {
#pragma unroll
            for (int i = 0; i < 3; ++i) { p0[i] = state_conv[(size_t)((ci - 512) * 3 + i) * 1024 + ch]; p1[i] = state_conv[(size_t)((ci - 512) * 3 + i) * 1024 + ch + 1]; }
        } else if (q == 0 && (ci & 63) == 0) {
#pragma unroll
            for (int i = 0; i < 3; ++i) { p0[i] = 0.f; p1[i] = 0.f; }
        } else {
#pragma unroll
            for (int i = 0; i < 3; ++i) { p0[i] = bflo(raw[i]); p1[i] = bfhi(raw[i]); }
        }
#pragma unroll
        for (int t8 = 0; t8 < 2; ++t8) {
            float y0[8], y1[8];
#pragma unroll
            for (int i = 0; i < 8; ++i) { const float x0 = bflo(raw[3 + t8 * 8 + i]), x1 = bfhi(raw[3 + t8 * 8 + i]);
                const float a0 = b0 + w0[0] * p0[0] + w0[1] * p0[1] + w0[2] * p0[2] + w0[3] * x0, a1 = b1 + w1[0] * p1[0] + w1[1] * p1[1] + w1[2] * p1[2] + w1[3] * x1;
                y0[i] = silu_f(a0); y1[i] = silu_f(a1); p0[0] = p0[1]; p0[1] = p0[2]; p0[2] = x0; p1[0] = p1[1]; p1[1] = p1[2]; p1[2] = x1; }
            v4u t0, t1; t0.x = pk2(y0[0], y0[1]); t0.y = pk2(y0[2], y0[3]); t0.z = pk2(y0[4], y0[5]); t0.w = pk2(y0[6], y0[7]);
            t1.x = pk2(y1[0], y1[1]); t1.y = pk2(y1[2], y1[3]); t1.z = pk2(y1[4], y1[5]); t1.w = pk2(y1[6], y1[7]);
            const int tl = q * 16 + t8 * 8;
            if (tid < 256) { const int h = ch >> 6, p = ch & 63; bf16* d = XT + ((size_t)(ci * 8 + h) * 64 + p) * 64 + tl; *(v4u*)d = t0; *(v4u*)(d + 64) = t1; }
            else if (tid < 384) { const int cb = ch - 512, g = cb >> 7, n = cb & 127;
#pragma unroll
                for (int i = 0; i < 8; ++i) *(unsigned*)(BN + (size_t)(row0 + t8 * 8 + i) * 256 + cb) = pk2(y0[i], y1[i]);
                bf16* d = BT + ((size_t)(ci * 2 + g) * 128 + n) * 64 + tl; *(v4u*)d = t0; *(v4u*)(d + 64) = t1; }
            else { const int cc = ch - 768;
#pragma unroll
                for (int i = 0; i < 8; ++i) *(unsigned*)(CN + (size_t)(row0 + t8 * 8 + i) * 256 + cc) = pk2(y0[i], y1[i]); }
        }
    }
}

#undef CONV_LD
__device__ __forceinline__ void ph_ssd_scan(const float* DT, const bf16* XT, const bf16* BT, bf16* HST, const float* state_ssm, const float* a_log, float* ssm_p, float* ssm_s, LAS unsigned char* lds, int vcu, int G, int tid) {
    asm volatile("" : "+v"(tid)); const int lane = tid & 63, wave = __builtin_amdgcn_readfirstlane(tid >> 6);
    const int fr = lane & 15, fq = lane >> 4;
    const int n_it = (G == 256) ? (vcu >= 128 ? 3 : 1) : (512 - vcu + G - 1) / G;
    for (int k = 0; k < n_it; ++k) {
        const int it = (G == 256) ? (k == 0 ? vcu : 256 + 2 * (vcu - 128) + (k - 1)) : vcu + k * G;
        const bool smp = it >= 256; const int id = it & 255, b = id >> 5, h = (id >> 2) & 7, pq = id & 3, g = h >> 2;
        const float A = -__expf(a_log[h]);
        const int p = pq * 16 + fr, n0 = 16 * wave + 4 * fq;
        f32x4 hst = (f32x4){0.f, 0.f, 0.f, 0.f};
        if (smp) hst = *(const f32x4*)(state_ssm + ((size_t)(b * 8 + h) * 64 + p) * 128 + n0);
        const int nch = smp ? 1 : 64, ci0 = smp ? 512 + b : b * 64;
        LAS float* sWg = (LAS float*)lds;
        LAS float* sDec = (LAS float*)(lds + 16384);
        __syncthreads();
        for (int c = wave; c < nch; c += NWAVES) { const float dtv = DT[(size_t)((ci0 + c) * 64 + lane) * 8 + h]; const float a = wave_incl_scan(dtv * A, lane); const float tot = __shfl(a, 63);
            sWg[c * 64 + lane] = dtv * __expf(tot - a); if (lane == 0) sDec[c] = __expf(tot); }
        __syncthreads();
        if (!smp) {
        LAS unsigned char* sX = lds + 32768;
        bf16x8 br[8][2];
#define SCAN_LD(u, cc) do { const int cl_ = ci0 + (cc); _Pragma("unroll") for (int ks = 0; ks < 2; ++ks) \
            br[u][ks] = *(const bf16x8*)(BT + ((size_t)(cl_ * 2 + g) * 128 + 16 * wave + fr) * 64 + 32 * ks + 8 * fq); } while (0)
#pragma unroll
        for (int u = 0; u < 8; ++u) SCAN_LD(u, u);
        for (int half = 0; half < 2; ++half) {
            __syncthreads();
            { bf16x8 xq[4][2];
#pragma unroll
              for (int i = 0; i < 4; ++i) { const int cq = ci0 + 32 * half + wave + 8 * i;
#pragma unroll
                  for (int ks = 0; ks < 2; ++ks) xq[i][ks] = *(const bf16x8*)(XT + ((size_t)(cq * 8 + h) * 64 + p) * 64 + 32 * ks + 8 * fq); }
#pragma unroll
              for (int i = 0; i < 4; ++i) { const int cl = wave + 8 * i, c = 32 * half + cl;
#pragma unroll
                  for (int ks = 0; ks < 2; ++ks) { const v4u xw = __builtin_bit_cast(v4u, xq[i][ks]); v4u o;
                      const f32x4 w0 = *(const LAS f32x4*)(sWg + c * 64 + 32 * ks + 8 * fq), w1 = *(const LAS f32x4*)(sWg + c * 64 + 32 * ks + 8 * fq + 4);
                      o[0] = pk2(bflo(xw[0]) * w0[0], bfhi(xw[0]) * w0[1]); o[1] = pk2(bflo(xw[1]) * w0[2], bfhi(xw[1]) * w0[3]); o[2] = pk2(bflo(xw[2]) * w1[0], bfhi(xw[2]) * w1[1]); o[3] = pk2(bflo(xw[3]) * w1[2], bfhi(xw[3]) * w1[3]);
                      *(LAS v4u*)(sX + (cl * 16 + fr) * 144 + 64 * ks + 16 * fq) = o; } } }
            __syncthreads();
            for (int c0 = 32 * half; c0 < 32 * half + 32; c0 += 8) {
#pragma unroll
                for (int u = 0; u < 8; ++u) { const int c = c0 + u, ci = ci0 + c, cl = c - 32 * half;
                    f32x4 st = (f32x4){0.f, 0.f, 0.f, 0.f};
#pragma unroll
                    for (int ks = 0; ks < 2; ++ks) { const bf16x8 xa = *(const LAS bf16x8*)(sX + (cl * 16 + fr) * 144 + 64 * ks + 16 * fq);
                        st = __builtin_amdgcn_mfma_f32_16x16x32_bf16(br[u][ks], xa, st, 0, 0, 0); }
                    { const int cn = (c + 8 < 64) ? c + 8 : 63; SCAN_LD(u, cn); }
                    v2u hs; hs.x = pk2(hst[0], hst[1]); hs.y = pk2(hst[2], hst[3]);
                    *(v2u*)(HST + ((size_t)(ci * 8 + h) * 64 + p) * 128 + n0) = hs;
                    hst = hst * sDec[c] + st; }
            }
        }
#undef SCAN_LD
        } else {
        bf16x8 xa_n[2], bb_n[2];
#pragma unroll
        for (int ks = 0; ks < 2; ++ks) { xa_n[ks] = *(const bf16x8*)(XT + ((size_t)(ci0 * 8 + h) * 64 + p) * 64 + 32 * ks + 8 * fq); bb_n[ks] = *(const bf16x8*)(BT + ((size_t)(ci0 * 2 + g) * 128 + 16 * wave + fr) * 64 + 32 * ks + 8 * fq); }
        for (int c = 0; c < nch; ++c) {
            const int ci = ci0 + c;
            bf16x8 xa[2], bb[2];
#pragma unroll
            for (int ks = 0; ks < 2; ++ks) { xa[ks] = xa_n[ks]; bb[ks] = bb_n[ks]; }
            if (c + 1 < nch) { const int cn = ci + 1;
#pragma unroll
                for (int ks = 0; ks < 2; ++ks) { xa_n[ks] = *(const bf16x8*)(XT + ((size_t)(cn * 8 + h) * 64 + p) * 64 + 32 * ks + 8 * fq); bb_n[ks] = *(const bf16x8*)(BT + ((size_t)(cn * 2 + g) * 128 + 16 * wave + fr) * 64 + 32 * ks + 8 * fq); } }
            f32x4 st = (f32x4){0.f, 0.f, 0.f, 0.f};
#pragma unroll
            for (int ks = 0; ks < 2; ++ks) { const v4u xw = __builtin_bit_cast(v4u, xa[ks]); v4u o;
                const f32x4 w0 = *(const LAS f32x4*)(sWg + c * 64 + 32 * ks + 8 * fq), w1 = *(const LAS f32x4*)(sWg + c * 64 + 32 * ks + 8 * fq + 4);
                o[0] = pk2(bflo(xw[0]) * w0[0], bfhi(xw[0]) * w0[1]); o[1] = pk2(bflo(xw[1]) * w0[2], bfhi(xw[1]) * w0[3]); o[2] = pk2(bflo(xw[2]) * w1[0], bfhi(xw[2]) * w1[1]); o[3] = pk2(bflo(xw[3]) * w1[2], bfhi(xw[3]) * w1[3]);
                st = __builtin_amdgcn_mfma_f32_16x16x32_bf16(bb[ks], __builtin_bit_cast(bf16x8, o), st, 0, 0, 0); }
            v2u hs; hs.x = pk2(hst[0], hst[1]); hs.y = pk2(hst[2], hst[3]);
            *(v2u*)(HST + ((size_t)(ci * 8 + h) * 64 + p) * 128 + n0) = hs;
            hst = hst * sDec[c] + st;
        }
        }
        float* dst = smp ? ssm_s : ssm_p;
        *(f32x4*)(dst + ((size_t)(b * 8 + h) * 64 + p) * 128 + n0) = hst;
    }
}

template <int NMT> __device__ __forceinline__ void ssd_out_item(const int ci, const int mt0, const float* DT, const bf16* XT, const bf16* BN, const bf16* CN, const bf16* HST, const bf16* Z, const float* ssd_norm,
                                                                bf16* MIXA, LAS unsigned char* lds, const float A, const float Dh, const int lane, const int wave) {
    LAS float* sCB = (LAS float*)lds;
    LAS float* sAcs = (LAS float*)(lds + 34816);
    LAS float* sDt = (LAS float*)(lds + 36864);
    LAS float* sSS = (LAS float*)(lds + 38912);
    const int h = wave, g = h >> 2, fr = lane & 15, fq = lane >> 4;
        const int row0 = ci * 64;
        { const float dtv = DT[(size_t)(row0 + lane) * 8 + h]; const float a = wave_incl_scan(dtv * A, lane); sAcs[h * 64 + lane] = a; sDt[h * 64 + lane] = dtv; }
        if (NMT == 4 || (wave & 3) == 0) { const int mt = 0, mt0c = (NMT == 4) ? (wave & 3) : mt0; bf16x8 cf[4];
#pragma unroll
          for (int ks = 0; ks < 4; ++ks) cf[ks] = *(const bf16x8*)(CN + (size_t)(row0 + 16 * mt0c + fr) * 256 + g * 128 + 32 * ks + 8 * fq);
#pragma unroll
          for (int st = 0; st < 4; ++st) { f32x4 acc = (f32x4){0.f, 0.f, 0.f, 0.f};
#pragma unroll
              for (int ks = 0; ks < 4; ++ks) { const bf16x8 bfv = *(const bf16x8*)(BN + (size_t)(row0 + 16 * st + fr) * 256 + g * 128 + 32 * ks + 8 * fq); acc = __builtin_amdgcn_mfma_f32_16x16x32_bf16(bfv, cf[ks], acc, 0, 0, 0); }
              *(LAS f32x4*)(sCB + (g * 64 + 16 * mt0c + fr) * 68 + 16 * st + 4 * fq) = acc; } }
        __syncthreads();
        f32x4 acc[4][NMT];
#pragma unroll
        for (int nt = 0; nt < 4; ++nt)
#pragma unroll
            for (int mt = 0; mt < NMT; ++mt) acc[nt][mt] = (f32x4){0.f, 0.f, 0.f, 0.f};
#pragma unroll
        for (int ks = 0; ks < 2; ++ks) {
            bf16x8 xf[4];
#pragma unroll
            for (int nt = 0; nt < 4; ++nt) xf[nt] = *(const bf16x8*)(XT + ((size_t)(ci * 8 + h) * 64 + 16 * nt + fr) * 64 + 32 * ks + 8 * fq);
            const int s0 = 32 * ks + 8 * fq;
            const f32x4 as0 = *(const LAS f32x4*)(sAcs + h * 64 + s0), as1 = *(const LAS f32x4*)(sAcs + h * 64 + s0 + 4), d0 = *(const LAS f32x4*)(sDt + h * 64 + s0), d1 = *(const LAS f32x4*)(sDt + h * 64 + s0 + 4);
#pragma unroll
            for (int mt = 0; mt < NMT; ++mt) { const int l = 16 * (mt0 + mt) + fr; const float al = sAcs[h * 64 + l];
                const f32x4 c0 = *(const LAS f32x4*)(sCB + (g * 64 + l) * 68 + s0), c1 = *(const LAS f32x4*)(sCB + (g * 64 + l) * 68 + s0 + 4);
                float mv[8];
#pragma unroll
                for (int j = 0; j < 4; ++j) { mv[j] = (s0 + j <= l) ? c0[j] * __expf(fminf(al - as0[j], 0.f)) * d0[j] : 0.f; mv[4 + j] = (s0 + 4 + j <= l) ? c1[j] * __expf(fminf(al - as1[j], 0.f)) * d1[j] : 0.f; }
#pragma unroll
                for (int j = 0; j < 8; ++j) if (s0 + j == l) mv[j] += Dh;
                v4u mw; mw.x = pk2(mv[0], mv[1]); mw.y = pk2(mv[2], mv[3]); mw.z = pk2(mv[4], mv[5]); mw.w = pk2(mv[6], mv[7]);
                const bf16x8 mf = __builtin_bit_cast(bf16x8, mw);
#pragma unroll
                for (int nt = 0; nt < 4; ++nt) acc[nt][mt] = __builtin_amdgcn_mfma_f32_16x16x32_bf16(xf[nt], mf, acc[nt][mt], 0, 0, 0); }
        }
#pragma unroll
        for (int ks = 0; ks < 4; ++ks) {
            bf16x8 hf[4];
#pragma unroll
            for (int nt = 0; nt < 4; ++nt) hf[nt] = *(const bf16x8*)(HST + ((size_t)(ci * 8 + h) * 64 + 16 * nt + fr) * 128 + 32 * ks + 8 * fq);
#pragma unroll
            for (int mt = 0; mt < NMT; ++mt) { const int l = 16 * (mt0 + mt) + fr; const float e = __expf(sAcs[h * 64 + l]);
                const v4u cw = *(const v4u*)(CN + (size_t)(row0 + l) * 256 + g * 128 + 32 * ks + 8 * fq); v4u o;
#pragma unroll
                for (int j = 0; j < 4; ++j) o[j] = pk2(bflo(cw[j]) * e, bfhi(cw[j]) * e);
                const bf16x8 cs = __builtin_bit_cast(bf16x8, o);
#pragma unroll
                for (int nt = 0; nt < 4; ++nt) acc[nt][mt] = __builtin_amdgcn_mfma_f32_16x16x32_bf16(hf[nt], cs, acc[nt][mt], 0, 0, 0); }
        }
#pragma unroll
        for (int mt = 0; mt < NMT; ++mt) { float ss = 0.f;
#pragma unroll
            for (int nt = 0; nt < 4; ++nt) { const v2u zr = *(const v2u*)(Z + (size_t)(row0 + 16 * (mt0 + mt) + fr) * 512 + h * 64 + 16 * nt + 4 * fq);
                f32x4 y = acc[nt][mt]; y[0] *= silu_f(bflo(zr.x)); y[1] *= silu_f(bfhi(zr.x)); y[2] *= silu_f(bflo(zr.y)); y[3] *= silu_f(bfhi(zr.y)); acc[nt][mt] = y;
                ss += (y[0] * y[0] + y[1] * y[1]) + (y[2] * y[2] + y[3] * y[3]); }
            ss += __shfl_xor(ss, 16); ss += __shfl_xor(ss, 32);
            if (fq == 0) sSS[h * 64 + 16 * (mt0 + mt) + fr] = ss; }
        __syncthreads();
#pragma unroll
        for (int mt = 0; mt < NMT; ++mt) { const int l = 16 * (mt0 + mt) + fr; float tot = 0.f;
#pragma unroll
            for (int w = 0; w < 8; ++w) tot += sSS[w * 64 + l];
            const float rstd = rsqrtf(tot * (1.0f / 512.0f) + EPSN);
#pragma unroll
            for (int nt = 0; nt < 4; ++nt) { const f32x4 nw = *(const f32x4*)(ssd_norm + h * 64 + 16 * nt + 4 * fq); const f32x4 o = acc[nt][mt] * rstd * nw;
                v2u ow; ow.x = pk2(o[0], o[1]); ow.y = pk2(o[2], o[3]); *(v2u*)(MIXA + (size_t)(row0 + l) * 1024 + h * 64 + 16 * nt + 4 * fq) = ow; } }
        __syncthreads();
}
__device__ __forceinline__ void ph_ssd_out(const float* DT, const bf16* XT, const bf16* BN, const bf16* CN, const bf16* HST, const bf16* Z, const float* a_log, const float* d_skip, const float* ssd_norm,
                                           bf16* MIXA, LAS unsigned char* lds, int vcu, int G, int tid) {
    asm volatile("" : "+v"(tid)); const int lane = tid & 63, wave = __builtin_amdgcn_readfirstlane(tid >> 6);
    const float A = -__expf(a_log[wave]), Dh = d_skip[wave];
    for (int ci = vcu; ci < 512; ci += G) ssd_out_item<4>(ci, 0, DT, XT, BN, CN, HST, Z, ssd_norm, MIXA, lds, A, Dh, lane, wave);
    for (int it = vcu; it < 32; it += G) ssd_out_item<1>(512 + (it >> 2), it & 3, DT, XT, BN, CN, HST, Z, ssd_norm, MIXA, lds, A, Dh, lane, wave);
}

__device__ __forceinline__ void ph_combine(const bf16* ATTO, const bf16* ATTOS, const float* MISC, bf16* MIXA, int vcu, int G, int tid, int row_lo) {
    asm volatile("" : "+v"(tid)); const int lane = tid & 63, gw = vcu * NWAVES + __builtin_amdgcn_readfirstlane(tid >> 6), NGW = G * NWAVES;
    const float lam = MISC[0];
    const int hh = lane >> 4, e0 = (lane & 15) * 8;
    v4u an = (v4u){0u, 0u, 0u, 0u}, bn = an;
    const int gs = row_lo + gw;
    if (gs < MT) { const bf16* orow = gs < MP ? ATTO + (size_t)gs * 1024 : ATTOS + (size_t)(((gs - MP) >> 6) * 256 + (gs & 63)) * 1024; an = *(const v4u*)(orow + (hh * 2) * 128 + e0); bn = *(const v4u*)(orow + (hh * 2 + 1) * 128 + e0); }
    for (int row = gs; row < MT; row += NGW) {
        const v4u a = an, b = bn;
        { const int rn = row + NGW; if (rn < MT) { const bf16* orow = rn < MP ? ATTO + (size_t)rn * 1024 : ATTOS + (size_t)(((rn - MP) >> 6) * 256 + (rn & 63)) * 1024; an = *(const v4u*)(orow + (hh * 2) * 128 + e0); bn = *(const v4u*)(orow + (hh * 2 + 1) * 128 + e0); } }
        float o[8]; float ss = 0.f;
#pragma unroll
        for (int j = 0; j < 4; ++j) { o[2 * j] = bflo(a[j]) - lam * bflo(b[j]); o[2 * j + 1] = bfhi(a[j]) - lam * bfhi(b[j]); ss += o[2 * j] * o[2 * j] + o[2 * j + 1] * o[2 * j + 1]; }
        ss += __shfl_xor(ss, 1); ss += __shfl_xor(ss, 2); ss += __shfl_xor(ss, 4); ss += __shfl_xor(ss, 8);
        const float r = rsqrtf(ss * (1.0f / 128.0f) + EPSN) * 0.8f;
        v4u w; w.x = pk2(o[0] * r, o[1] * r); w.y = pk2(o[2] * r, o[3] * r); w.z = pk2(o[4] * r, o[5] * r); w.w = pk2(o[6] * r, o[7] * r);
        *(v4u*)(MIXA + (size_t)row * 1024 + 512 + hh * 128 + e0) = w;
    }
}

__device__ __forceinline__ void ph_final(const bf16* X3, float* Y, const float* w, int vcu, int G, int tid, const bf16* fslab, int fS, const float* fgate, float fsc) {
    asm volatile("" : "+v"(tid)); const int lane = tid & 63, gw = vcu * NWAVES + __builtin_amdgcn_readfirstlane(tid >> 6), NGW = G * NWAVES;
    f32x4 wv[4];
#pragma unroll
    for (int j = 0; j < 4; ++j) wv[j] = ((const f32x4*)w)[lane + 64 * j];
    f32x4 vn[4];
    if (gw < MT) load_row4(X3, true, (size_t)gw, lane, vn);
    for (int row = gw; row < MT; row += NGW) {
        f32x4 v[4]; float s = 0.f;
#pragma unroll
        for (int j = 0; j < 4; ++j) v[j] = vn[j];
        if (row + NGW < MT) load_row4(X3, true, (size_t)(row + NGW), lane, vn);
        if (row >= MP) { const int mb = 8 + ((row - MP) >> 6);
            f32x4 a[4];
#pragma unroll
            for (int j = 0; j < 4; ++j) a[j] = (f32x4){0.f, 0.f, 0.f, 0.f};
            for (int ks = 0; ks < fS; ++ks) { const v2u* sp = (const v2u*)(fslab + ((size_t)ks * MS + (row - MP)) * DM);
#pragma unroll
                for (int j = 0; j < 4; ++j) { const v2u r = sp[lane + 64 * j]; a[j] += (f32x4){bflo(r.x), bfhi(r.x), bflo(r.y), bfhi(r.y)}; } }
#pragma unroll
            for (int j = 0; j < 4; ++j) v[j] += ((const f32x4*)(fgate + (size_t)mb * 9216))[lane + 64 * j] * fsc * a[j];
        }
#pragma unroll
        for (int j = 0; j < 4; ++j) s += (v[j][0] * v[j][0] + v[j][1] * v[j][1]) + (v[j][2] * v[j][2] + v[j][3] * v[j][3]);
        const float rstd = rsqrtf(wave_sum(s) * (1.0f / DM) + EPSN);
        f32x4* yr = (f32x4*)(Y + (size_t)row * DM);
#pragma unroll
        for (int j = 0; j < 4; ++j) yr[lane + 64 * j] = v[j] * rstd * wv[j];
    }
}

__device__ __forceinline__ int opq(int v) { asm volatile("" : "+s"(v)); return v; }
__device__ __forceinline__ void finish_gu(const bf16* slab, unsigned char* ACT8, int vcu, int G, int tid) {
    asm volatile("" : "+v"(tid)); const int gt = vcu * 512 + tid, NT_ = G * 512;
    for (int i = gt; i < 512 * 704; i += NT_) { const int r = i / 704, f = (i - r * 704) * 4, c = (f >> 7) * 256 + (f & 127);
        f32x4 g = (f32x4){0.f, 0.f, 0.f, 0.f}, u = g;
#pragma unroll
        for (int ks = 0; ks < 2; ++ks) { const bf16* p = slab + ((size_t)ks * 512 + r) * NGU + c; const v2u gr = *(const v2u*)p, ur = *(const v2u*)(p + 128);
            g += (f32x4){bflo(gr.x), bfhi(gr.x), bflo(gr.y), bfhi(gr.y)}; u += (f32x4){bflo(ur.x), bfhi(ur.x), bflo(ur.y), bfhi(ur.y)}; }
        g = g * INV_GU; u = u * (INV_GU * SC_ACT8);
        *(unsigned*)(ACT8 + (size_t)(MP + r) * DFF + f) = pk4_fp8(silu_f(g[0]) * u[0], silu_f(g[1]) * u[1], silu_f(g[2]) * u[2], silu_f(g[3]) * u[3]); }
}
__device__ __forceinline__ void finish_in(const bf16* slab, unsigned char* ws, float* out, float qscale, int vcu, int G, int tid) {
    asm volatile("" : "+v"(tid)); const int gt = vcu * 512 + tid, NT_ = G * 512;
    for (int i = gt; i < 512 * 384; i += NT_) { const int r = i / 384, c = (i - r * 384) * 8;
        f32x4 v0 = (f32x4){0.f, 0.f, 0.f, 0.f}, v1 = v0;
#pragma unroll
        for (int ks = 0; ks < 2; ++ks) { const v4u r4 = *(const v4u*)(slab + ((size_t)ks * 512 + r) * NIN + c); v0 += (f32x4){bflo(r4.x), bfhi(r4.x), bflo(r4.y), bfhi(r4.y)}; v1 += (f32x4){bflo(r4.z), bfhi(r4.z), bflo(r4.w), bfhi(r4.w)}; }
        pg8::route_in(ws, out, qscale, MP + r, c, v0, v1); }
}
__device__ __forceinline__ void flag_arrive(unsigned* cnt, int tid) {
    asm volatile("s_waitcnt vmcnt(0)" ::: "memory"); __syncthreads();
    if (tid == 0) { __builtin_amdgcn_fence(__ATOMIC_RELEASE, "agent"); asm volatile("s_waitcnt vmcnt(0)" ::: "memory"); (void)__hip_atomic_fetch_add(cnt, 1u, __ATOMIC_RELAXED, __HIP_MEMORY_SCOPE_AGENT); }
}
__device__ __forceinline__ void flag_wait(unsigned* cnt, unsigned want, int tid) {
    if (tid == 0) { unsigned sp = 0; while (__hip_atomic_load(cnt, __ATOMIC_RELAXED, __HIP_MEMORY_SCOPE_AGENT) < want) { __builtin_amdgcn_s_sleep(2); if (++sp > (1u << 22)) break; }
        __builtin_amdgcn_fence(__ATOMIC_ACQUIRE, "agent"); asm volatile("s_waitcnt vmcnt(0)" ::: "memory"); }
    __syncthreads();
}

#define XB_TMO      128
#define XB_XCNT(j)  (256  + 64 * (j))
#define XB_XSUB(j)  (1280 + 64 * (j))
#define XB_XGEN(j)  (2304 + 64 * (j))
#define XB_TOP      3328
#define XB_TOPGEN   3392
#define XCD_BAR_WORDS 3456
#define XB_SPIN_CAP (1u << 18)

__device__ __forceinline__ unsigned xb_ld(unsigned* p)              { return __hip_atomic_load(p, __ATOMIC_RELAXED, __HIP_MEMORY_SCOPE_AGENT); }
__device__ __forceinline__ unsigned xb_add(unsigned* p, unsigned v) { return __hip_atomic_fetch_add(p, v, __ATOMIC_RELAXED, __HIP_MEMORY_SCOPE_AGENT); }
__device__ __forceinline__ unsigned xb_xcc_id() { return (unsigned)__builtin_amdgcn_s_getreg((3 << 11) | 20) & 0xFu; }
#define XB_SPIN(cond, bar) do { unsigned _sp = 0; while (cond) { __builtin_amdgcn_s_sleep(1); \
    if ((++_sp & 255u) == 0u) { if (xb_ld(&(bar)[XB_TMO])) break; if (_sp > XB_SPIN_CAP) { atomicAdd(&(bar)[XB_TMO], 1u); break; } } } } while (0)

struct XcdBarrier {
    unsigned* bar; unsigned x;
    volatile LAS unsigned* st;
};

__device__ __forceinline__ XcdBarrier xcd_barrier_post(unsigned* bar, volatile LAS unsigned* st) {
    XcdBarrier b; b.bar = bar; b.x = xb_xcc_id(); b.st = st;
    if (threadIdx.x == 0) (void)xb_add(&bar[XB_XCNT(b.x)], 1u);
    return b;
}
__device__ __forceinline__ void xcd_barrier_complete(unsigned* bar, unsigned x, unsigned& nloc, unsigned& nx) {
    const unsigned G = gridDim.x * gridDim.y * gridDim.z;
    unsigned sum, cnt, mine, sp = 0u;
    for (;;) {
        sum = 0u; cnt = 0u; mine = 0u;
#pragma unroll
        for (unsigned j = 0; j < 16; ++j) { const unsigned c = xb_ld(&bar[XB_XCNT(j)]); sum += c; cnt += (c > 0u) ? 1u : 0u; mine = (j == x) ? c : mine; }
        if (sum == G) break;
        __builtin_amdgcn_s_sleep(1);
        if ((++sp & 255u) == 0u) { if (xb_ld(&bar[XB_TMO])) break; if (sp > XB_SPIN_CAP) { atomicAdd(&bar[XB_TMO], 1u); break; } }
    }
    nloc = mine > 0u ? mine : 1u; nx = cnt > 0u ? cnt : 1u;
}

__device__ __forceinline__ void xcd_barrier(const XcdBarrier& b) {
    asm volatile("s_waitcnt vmcnt(0)" ::: "memory");
    __syncthreads();
    if (threadIdx.x == 0) {
        unsigned* bar = b.bar;
        __builtin_amdgcn_s_waitcnt(0);
        unsigned nloc = b.st[0], nx = b.st[1];
        if (nloc == 0u) { xcd_barrier_complete(bar, b.x, nloc, nx); b.st[0] = nloc; b.st[1] = nx; }
        const unsigned old = xb_add(&bar[XB_XSUB(b.x)], 1u);
        const unsigned gen = old / nloc;
        if (old + 1u == (gen + 1u) * nloc) {
            __builtin_amdgcn_fence(__ATOMIC_RELEASE, "agent");
            asm volatile("s_waitcnt vmcnt(0)" ::: "memory");
            const unsigned og = xb_add(&bar[XB_TOP], 1u);
            const unsigned tg = og / nx;
            if (og + 1u == (tg + 1u) * nx) xb_add(&bar[XB_TOPGEN], 1u);
            else XB_SPIN(xb_ld(&bar[XB_TOPGEN]) == tg, bar);
            __builtin_amdgcn_fence(__ATOMIC_ACQUIRE, "agent");
            xb_add(&bar[XB_XGEN(b.x)], 1u);
            asm volatile("s_waitcnt vmcnt(0)" ::: "memory");
        } else {
            XB_SPIN(xb_ld(&bar[XB_XGEN(b.x)]) == gen, bar);
            __builtin_amdgcn_fence(__ATOMIC_ACQUIRE, "agent");
            asm volatile("s_waitcnt vmcnt(0)" ::: "memory");
        }
    }
    __syncthreads();
}

template <int I> __device__ __forceinline__ const float* karg_in() {
    unsigned long long v;
    asm volatile("s_load_dwordx2 %0, %1, %2\n\ts_waitcnt lgkmcnt(0)" : "=s"(v) : "s"(__builtin_amdgcn_kernarg_segment_ptr()), "n"(I * 8) : "memory");
    return (const float*)v;
}
struct Args { const float* in[30]; float* out; unsigned char* ws; int ph_lo, ph_hi, coop, pad; };
__global__ void __launch_bounds__(NWAVES * 64, 2) mk_fwd(Args args) {
    extern __shared__ __attribute__((aligned(16))) unsigned char lds[];
    LAS unsigned char* L = (LAS unsigned char*)lds;
    const int tid = threadIdx.x;
    const int G = gridDim.x, bx = blockIdx.x; const int vcu = (G % 8 == 0) ? (bx % 8) * (G / 8) + bx / 8 : bx;
    unsigned char* ws = args.ws; float* out = args.out;
#define MOD ((float*)(ws + WS_MOD))
#define MISC ((float*)(ws + WS_MISC))
#define DT ((float*)(ws + WS_DT))
#define Wgu1 ((bf16*)(ws + WS_WGU1))
#define Wd1 ((bf16*)(ws + WS_WD1))
#define Win ((bf16*)(ws + WS_WIN))
#define Wout ((bf16*)(ws + WS_WOUT))
#define Wgu2 ((bf16*)(ws + WS_WGU2))
#define Wd2 ((bf16*)(ws + WS_WD2))
#define H ((bf16*)(ws + WS_H))
#define ACT ((bf16*)(ws + WS_ACT))
#define XBC ((bf16*)(ws + WS_XBC))
#define Zb ((bf16*)(ws + WS_Z))
#define Qb ((bf16*)(ws + WS_Q))
#define Kb ((bf16*)(ws + WS_K))
#define Vb ((bf16*)(ws + WS_V))
#define KS ((bf16*)(ws + WS_KS))
#define VS ((bf16*)(ws + WS_VS))
#define XT ((bf16*)(ws + WS_XT))
#define BN ((bf16*)(ws + WS_BN))
#define CN ((bf16*)(ws + WS_CN))
#define BT ((bf16*)(ws + WS_BT))
#define HST ((bf16*)(ws + WS_HST))
#define ATTO ((bf16*)(ws + WS_ATTO))
#define ATTOS ((bf16*)(ws + WS_ATTOS))
#define XB ((bf16*)out)
#define X3 ((bf16*)(ws + WS_H))
    const int lo = args.ph_lo, hi = args.ph_hi;
    volatile LAS unsigned* LCTL = (volatile LAS unsigned*)(L + 131072);
    if (tid < 64) LCTL[tid] = 0u;
    __syncthreads();
    XcdBarrier bar; bar.bar = (unsigned*)(ws + WS_CTL) + 4096; bar.x = 0; bar.st = nullptr;
    if (args.coop) bar = xcd_barrier_post((unsigned*)(ws + WS_CTL) + 4096, LCTL + 8);
#define IN(k) (lo <= (k) && (k) < hi)
#define CNT(i) ((unsigned*)(ws + WS_CTL) + 8192 + 64 * (i))
#ifndef REP_MASK
#define REP_MASK 0
#endif
#define REPS(k) (((REP_MASK >> (k)) & 1) ? 2 : 1)
#define SEAM(k) do { if (IN(k) && IN((k) + 1)) { xcd_barrier(bar); } } while (0)

    if (IN(0)) for (int rep_ = 0; rep_ < REPS(0); ++rep_) { ph_mod(karg_in<6>(), karg_in<7>(), karg_in<8>(), karg_in<9>(), MOD, MISC, karg_in<21>(), karg_in<22>(), karg_in<23>(), karg_in<24>(), L, G, tid); flag_arrive(CNT(3), tid); }
    if (args.coop == 2) cg::this_grid().sync();
    if (IN(1)) for (int rep_ = 0; rep_ < REPS(1); ++rep_) {
        int t1 = tid; asm volatile("" : "+v"(t1)); const int lane = t1 & 63, wave = __builtin_amdgcn_readfirstlane(t1 >> 6), gw = vcu * NWAVES + wave, NGW = G * NWAVES;
        LAS float* scr = (LAS float*)(L + wave * 16384);
        constexpr int I_GU = (DM / 64) * (NGU / 32), I_D = (DFF / 64) * (DM / 32), I_IN = (DM / 64) * ((INC + 31) / 32), I_O = (DM / 64) * (DM / 32);
        constexpr int NITEMS = 2 * I_GU + 2 * I_D + I_IN + I_O;
        for (int it = gw; it < NITEMS; it += NGW) { int r = it;
            if (r < I_GU) { transpose_item<1, true>(karg_in<11>(), DM, NGU, Wgu1, scr, r, lane, SC_WGU8); continue; } r -= I_GU;
            if (r < I_GU) { transpose_item<1, true>(karg_in<27>(), DM, NGU, Wgu2, scr, r, lane, SC_WGU8); continue; } r -= I_GU;
            if (r < I_D) { transpose_item<0, true>(karg_in<12>(), DFF, DM, Wd1, scr, r, lane, SC_WD8); continue; } r -= I_D;
            if (r < I_D) { transpose_item<0, true>(karg_in<28>(), DFF, DM, Wd2, scr, r, lane, SC_WD8); continue; } r -= I_D;
            if (r < I_IN) { transpose_item<2, false>(karg_in<14>(), DM, INC, Win, scr, r, lane, 1.0f); continue; } r -= I_IN;
            transpose_item<0, false>(karg_in<25>(), DM, DM, Wout, scr, r, lane, 1.0f);
        }
        { const float* ck = karg_in<2>(); const float* cv = karg_in<3>(); const int gt = vcu * 512 + tid, NT_ = G * 512;
          for (int i0 = gt; i0 < 8 * 2048 * 64; i0 += 2 * NT_) {
              f32x4 a0[2], a1[2], b0[2], b1[2]; size_t dofs[2];
#pragma unroll
              for (int u = 0; u < 2; ++u) { const int i = i0 + u * NT_; const int c8 = i & 63, t = (i >> 6) & 2047, sb = i >> 17; const size_t so = ((size_t)(sb * 2048 + t) * 512 + c8 * 8); dofs[u] = ((size_t)(sb * 2176 + t) * 512 + c8 * 8);
                  const bool ok = i < 8 * 2048 * 64; const size_t s2 = ok ? so : 0; if (!ok) dofs[u] = (size_t)-1;
                  a0[u] = *(const f32x4*)(ck + s2); a1[u] = *(const f32x4*)(ck + s2 + 4); b0[u] = *(const f32x4*)(cv + s2); b1[u] = *(const f32x4*)(cv + s2 + 4); }
#pragma unroll
              for (int u = 0; u < 2; ++u) if (dofs[u] != (size_t)-1) { v4u w; w.x = pk2(a0[u][0], a0[u][1]); w.y = pk2(a0[u][2], a0[u][3]); w.z = pk2(a1[u][0], a1[u][1]); w.w = pk2(a1[u][2], a1[u][3]); *(v4u*)(KS + dofs[u]) = w;
                  w.x = pk2(b0[u][0], b0[u][1]); w.y = pk2(b0[u][2], b0[u][3]); w.z = pk2(b1[u][0], b1[u][1]); w.w = pk2(b1[u][2], b1[u][3]); *(v4u*)(VS + dofs[u]) = w; } }
          for (int i = gt; i < 8 * 64 * 64; i += NT_) { const int c8 = i & 63, t = (i >> 6) & 63, sb = i >> 12; const size_t dofs = ((size_t)(sb * 2176 + 2112 + t) * 512 + c8 * 8);
              *(v4u*)(KS + dofs) = (v4u){0u, 0u, 0u, 0u}; *(v4u*)(VS + dofs) = (v4u){0u, 0u, 0u, 0u}; } }
        flag_wait(CNT(3), (unsigned)G, tid);
        norm_mod_rows<false, true>(karg_in<0>(), false, karg_in<1>(), false, karg_in<10>(), MOD, 0, 1, H, vcu, G, tid, nullptr, nullptr, nullptr, nullptr, 0, nullptr, 0.f, nullptr);
    }
    SEAM(1);
    if (IN(2)) for (int rep_ = 0; rep_ < REPS(2); ++rep_) { { pg8::Gemm g{H, Wgu1, MP, NGU, DM / 2, DM / 2}; pg8::StaticOrder S; S.init(MP, NGU, G, bx); pg8::EpiSwiGLU E{(unsigned char*)ACT, DFF, INV_GU, SC_ACT8};
        pg8::gemm_phase<pg8::EpiSwiGLU, pg8::StaticOrder, true, true, true>(L, g, S, E); }
        { pg8::Gemm g{H, Wgu1, MS, NGU, opq(256), DM / 2}; pg8::SplitOrder S; S.init(2, NGU, 2, 256, MP / 256, G, vcu); pg8::EpiSlab E{(bf16*)(ws + WS_XT), NGU, 256};
        pg8::gemm_phase<pg8::EpiSlab, pg8::SplitOrder, true, true, true>(L, g, S, E); } }
    SEAM(2);
    if (IN(3)) for (int rep_ = 0; rep_ < REPS(3); ++rep_) { finish_gu((const bf16*)(ws + WS_XT), (unsigned char*)ACT, vcu, G, tid); flag_arrive(CNT(0), tid);
        { pg8::Gemm g{ACT, Wd1, MP, DM, DFF / 2, DFF / 2}; pg8::StaticOrder S; S.init(MP, DM, G, bx); pg8::EpiResidB<false> E{karg_in<0>(), XB, MOD + 2 * 1024, 0.5f * INV_D};
        pg8::gemm_phase<pg8::EpiResidB<false>, pg8::StaticOrder, true, true, true>(L, g, S, E); }
        flag_wait(CNT(0), (unsigned)G, tid);
        { pg8::Gemm g{ACT, Wd1, MS, DM, opq(128), DFF / 2}; pg8::SplitOrder S; S.init(2, DM, 11, 128, MP / 256, G, vcu); pg8::EpiSlab E{(bf16*)(ws + WS_HST), DM, 128};
        pg8::gemm_phase<pg8::EpiSlab, pg8::SplitOrder, true, true, true>(L, g, S, E); } }
    SEAM(3);
    if (IN(4)) for (int rep_ = 0; rep_ < REPS(4); ++rep_) {
        LAS float* sW = (LAS float*)L;
        for (int i = tid; i < 8192; i += 512) { const int c = i & 7, k = i >> 3; sW[c * 1024 + k] = karg_in<14>()[(size_t)k * INC + 1536 + c]; }
        __syncthreads();
        norm_mod_rows<true, false>(XB, true, karg_in<1>(), false, karg_in<13>(), MOD, 3, 4, H, vcu, G, tid, sW, karg_in<17>(), DT, (const bf16*)(ws + WS_HST), 11, MOD + 2 * 1024, 0.5f * INV_D, XB);
        __syncthreads();
    }
    SEAM(4);
    if (IN(5)) for (int rep_ = 0; rep_ < REPS(5); ++rep_) { { pg8::Gemm g{H, Win, MP, NIN, DM, DM}; pg8::StaticOrder S; S.init(MP, NIN, G, bx);
        pg8::EpiIn E{ws, out, 0.125f * 1.4426950408889634f};
        pg8::gemm_phase<pg8::EpiIn, pg8::StaticOrder, true, true>(L, g, S, E); }
        { pg8::Gemm g{H, Win, MS, NIN, opq(512), DM}; pg8::SplitOrder S; S.init(2, NIN, 2, 512, MP / 256, G, vcu); pg8::EpiSlab E{(bf16*)(ws + WS_HST), NIN, 512};
        pg8::gemm_phase<pg8::EpiSlab, pg8::SplitOrder, true, true>(L, g, S, E); } }
    SEAM(5);
    if (IN(6)) { finish_in((const bf16*)(ws + WS_HST), ws, out, 0.125f * 1.4426950408889634f, vcu, G, tid); flag_arrive(CNT(1), tid);
        ph_conv(XBC, karg_in<5>(), karg_in<15>(), karg_in<16>(), XT, BN, CN, BT, 0, 512, vcu, G, tid);
        flag_wait(CNT(1), (unsigned)G, tid);
        ph_conv(XBC, karg_in<5>(), karg_in<15>(), karg_in<16>(), XT, BN, CN, BT, 512, NCH, vcu, G, tid); }
    SEAM(6);
    if (IN(7)) for (int rep_ = 0; rep_ < REPS(7); ++rep_) { ph_ssd_scan(DT, XT, BT, HST, karg_in<4>(), karg_in<18>(), out + O_SSMP, out + O_SSMS, L, vcu, G, tid); }
    if (IN(7)) { __syncthreads();
        { const float lam = MISC[0];
        for (int v = vcu; v < 256; v += G) {
            const int bh = v >> 3, s = v & 7, b = bh >> 2, hd = bh & 3;
            int ring0 = 0; bool primed = false;
            for (int i = 0; i < 8; ++i) { const int qb = (i >> 2) ? 15 - s : s, j = (i >> 1) & 1, vh = i & 1;
                const bf16* Qp = Qb + (size_t)(b * 4096 + qb * 256) * 512 + (hd * 2 + j) * 64; const bf16* Kp = Kb + (size_t)(b * 4096) * 512 + (hd * 2 + j) * 64; const bf16* Vp = Vb + (size_t)(b * 4096) * 512 + (hd * 2 + vh) * 64;
                bf16* Op = ATTO + (size_t)(b * 4096 + qb * 256) * 1024 + ((hd * 2 + j) * 2 + vh) * 64;
                bf16* Mp = ((i & 3) == 3) ? H + (size_t)(b * 4096 + qb * 256) * 1024 + 512 + hd * 128 : nullptr;
                const bool more = i < 7; const int jn = ((i + 1) >> 1) & 1, vn = (i + 1) & 1;
                const bf16* nK = Kb + (size_t)(b * 4096) * 512 + (hd * 2 + jn) * 64; const bf16* nV = Vb + (size_t)(b * 4096) * 512 + (hd * 2 + vn) * 64;
                ring0 = attn_body::attn_unit<8, false>((const attn_body::bf16*)Qp, (const attn_body::bf16*)Kp, (const attn_body::bf16*)Vp, (attn_body::bf16*)Op, 4 * (qb + 1), -1, (char*)lds, ring0, primed,
                                                       more ? (const attn_body::bf16*)nK : nullptr, more ? (const attn_body::bf16*)nV : nullptr, (attn_body::bf16*)Mp, lam); primed = more; }
        } }
        for (int v = vcu; v < 128; v += G) {
            const int grp = v, vh = grp & 1, j = (grp >> 1) & 1, hd = (grp >> 2) & 3, sb = grp >> 4;
            const bf16* Qp = Qb + (size_t)(MP + sb * 256) * 512 + (hd * 2 + j) * 64; const bf16* Kp = KS + (size_t)(sb * 2176) * 512 + (hd * 2 + j) * 64; const bf16* Vp = VS + (size_t)(sb * 2176) * 512 + (hd * 2 + vh) * 64;
            bf16* Op = ATTOS + (size_t)(sb * 256) * 1024 + ((hd * 2 + j) * 2 + vh) * 64;
            attn_body::attn_unit<8, true>((const attn_body::bf16*)Qp, (const attn_body::bf16*)Kp, (const attn_body::bf16*)Vp, (attn_body::bf16*)Op, 34, 2, (char*)lds, 0, false, nullptr, nullptr, nullptr, 0.f);
        }
    }
    SEAM(7);
    if (IN(8)) for (int rep_ = 0; rep_ < REPS(8); ++rep_) { ph_ssd_out(DT, XT, BN, CN, HST, Zb, karg_in<18>(), karg_in<19>(), karg_in<20>(), H, L, vcu, G, tid); }
    if (IN(8)) { ph_combine(ATTO, ATTOS, MISC, H, vcu, G, tid, MP); }
    SEAM(8);
    if (IN(11)) { { pg8::Gemm g{H, Wout, MP, DM, DM, DM}; pg8::StaticOrder S; S.init(MP, DM, G, bx); pg8::EpiResidB<true> E{XB, XB, MOD + 5 * 1024, 1.0f};
        pg8::gemm_phase<pg8::EpiResidB<true>, pg8::StaticOrder, true, true>(L, g, S, E); }
        { pg8::Gemm g{H, Wout, MS, DM, opq(512), DM}; pg8::SplitOrder S; S.init(2, DM, 2, 512, MP / 256, G, vcu); pg8::EpiSlab E{(bf16*)(ws + WS_XT + 48 * MiB), DM, 512};
        pg8::gemm_phase<pg8::EpiSlab, pg8::SplitOrder, true, true>(L, g, S, E); } }
    SEAM(11);
    if (IN(12)) for (int rep_ = 0; rep_ < REPS(12); ++rep_) { norm_mod_rows<false, true>(XB, true, XB + (size_t)MP * DM, true, karg_in<26>(), MOD, 6, 7, H, vcu, G, tid, nullptr, nullptr, nullptr, (const bf16*)(ws + WS_XT + 48 * MiB), 2, MOD + 5 * 1024, 1.0f, X3); }
    SEAM(12);
    if (IN(13)) { { pg8::Gemm g{H, Wgu2, MP, NGU, DM / 2, DM / 2}; pg8::StaticOrder S; S.init(MP, NGU, G, bx); pg8::EpiSwiGLU E{(unsigned char*)ACT, DFF, INV_GU, SC_ACT8};
        pg8::gemm_phase<pg8::EpiSwiGLU, pg8::StaticOrder, true, true, true>(L, g, S, E); }
        { pg8::Gemm g{H, Wgu2, MS, NGU, opq(256), DM / 2}; pg8::SplitOrder S; S.init(2, NGU, 2, 256, MP / 256, G, vcu); pg8::EpiSlab E{(bf16*)(ws + WS_XT), NGU, 256};
        pg8::gemm_phase<pg8::EpiSlab, pg8::SplitOrder, true, true, true>(L, g, S, E); } }
    SEAM(13);
    if (IN(14)) { finish_gu((const bf16*)(ws + WS_XT), (unsigned char*)ACT, vcu, G, tid); flag_arrive(CNT(2), tid);
        { pg8::Gemm g{ACT, Wd2, MP, DM, DFF / 2, DFF / 2}; pg8::StaticOrder S; S.init(MP, DM, G, bx); pg8::EpiResidB<true> E{XB, X3, MOD + 8 * 1024, 0.5f * INV_D};
        pg8::gemm_phase<pg8::EpiResidB<true>, pg8::StaticOrder, true, true, true>(L, g, S, E); }
        flag_wait(CNT(2), (unsigned)G, tid);
        { pg8::Gemm g{ACT, Wd2, MS, DM, opq(128), DFF / 2}; pg8::SplitOrder S; S.init(2, DM, 11, 128, MP / 256, G, vcu); pg8::EpiSlab E{(bf16*)(ws + WS_HST), DM, 128};
        pg8::gemm_phase<pg8::EpiSlab, pg8::SplitOrder, true, true, true>(L, g, S, E); } }
    SEAM(14);
    if (IN(15)) { ph_final(X3, out, karg_in<29>(), vcu, G, tid, (const bf16*)(ws + WS_HST), 11, MOD + 8 * 1024, 0.5f * INV_D); }
#undef IN
#undef SEAM
}

#ifndef MK_PER_PHASE
#define MK_PER_PHASE 0
#endif
extern "C" void kernel_launch(void* const* d_in, const int* in_sizes, int n_in, void* d_out, int out_size, void* d_ws, size_t ws_size, hipStream_t stream) {
    static int grid = 0;
    if (grid == 0) {
        if (n_in != 30 || (size_t)out_size != O_TOTAL || ws_size < WS_END) { fprintf(stderr, "kernel_launch: unexpected shapes (n_in %d out %d ws %zu)\n", n_in, out_size, ws_size); grid = -1; return; }
        int dev = 0, cus = 0, per_cu = 0;
        if (hipGetDevice(&dev) != hipSuccess || hipDeviceGetAttribute(&cus, hipDeviceAttributeMultiprocessorCount, dev) != hipSuccess) { grid = -1; return; }
        if (hipFuncSetAttribute((const void*)mk_fwd, hipFuncAttributeMaxDynamicSharedMemorySize, LDS_BYTES) != hipSuccess) { fprintf(stderr, "kernel_launch: hipFuncSetAttribute failed\n"); grid = -1; return; }
        if (hipOccupancyMaxActiveBlocksPerMultiprocessor(&per_cu, (const void*)mk_fwd, NWAVES * 64, LDS_BYTES) != hipSuccess || per_cu < 1) { fprintf(stderr, "kernel_launch: occupancy query says %d\n", per_cu); per_cu = 1; }
        (void)hipGetLastError();
        grid = cus * 1;
    }
    if (grid < 0) return;
    Args a{};
    for (int i = 0; i < 30; ++i) a.in[i] = (const float*)d_in[i];
    a.out = (float*)d_out; a.ws = (unsigned char*)d_ws;
#if MK_PER_PHASE
    for (int ph = 0; ph < N_PHASES; ++ph) { a.ph_lo = ph; a.ph_hi = ph + 1; a.coop = 0;
        hipLaunchKernelGGL(mk_fwd, dim3(grid), dim3(NWAVES * 64), LDS_BYTES, stream, a); }
#else
    if (hipMemsetAsync((char*)d_ws + WS_CTL, 0, CTL_ZERO_BYTES, stream) != hipSuccess) { fprintf(stderr, "kernel_launch: memset failed\n"); return; }
    a.ph_lo = 0; a.ph_hi = N_PHASES; a.coop = 1;
    void* kargs[] = {&a};
    hipError_t e = hipLaunchCooperativeKernel((const void*)mk_fwd, dim3(grid), dim3(NWAVES * 64), kargs, LDS_BYTES, stream);
    if (e != hipSuccess) fprintf(stderr, "kernel_launch: cooperative launch failed: %s (grid %d)\n", hipGetErrorString(e), grid);
#endif
}
```
